# Optimizing an MI355X kernel written in HIP

```python
import math
import jax, jax.numpy as jnp
from jax import lax
import numpy as np

D_MODEL = 2048
BATCH = 4
SEQ = 2048
DEPTH = 2

EPS = 1e-6
NEG_INF = -1e30

SSM_WIDTH = D_MODEL // 2
SSM_GROUP = 16
SSM_GROUPS = SSM_WIDTH // SSM_GROUP
SSM_STATE = 64
DT_MIN = 1e-3
DT_MAX = 1e-1

SG_WIDTH = D_MODEL // 2
SG_HEADS = 8
SG_HEAD_DIM = SG_WIDTH // SG_HEADS
SG_CHUNK = 128

HEAD_DIM = 64
ATT_HEADS = D_MODEL // 128
ATT_KV_HEADS = ATT_HEADS // 8
GQA_GROUP = ATT_HEADS // ATT_KV_HEADS
ATT_WIDTH = ATT_HEADS * HEAD_DIM
KV_WIDTH = ATT_KV_HEADS * HEAD_DIM
WINDOW = 128
ATT_BLOCK = 128
ROT_DIM = HEAD_DIM // 4
ROPE_THETA = 500000.0

N_BRANCH = 3
IN_SIZES = (SSM_WIDTH, SSM_WIDTH, SG_WIDTH, SG_WIDTH, SG_WIDTH,
            ATT_WIDTH, KV_WIDTH, KV_WIDTH, ATT_WIDTH, N_BRANCH * D_MODEL)
D_IN = sum(IN_SIZES)
IN_OFFSETS = tuple(sum(IN_SIZES[:i + 1]) for i in range(len(IN_SIZES) - 1))

kernel_name = "hybrid_s5_gmlp_swa_gated_block"


def rmsnorm(x, w):
    xf = x.astype(jnp.float32)
    y = xf * lax.rsqrt(jnp.mean(xf * xf, axis=-1, keepdims=True) + EPS)
    return (y * w.astype(jnp.float32)).astype(x.dtype)


def layernorm(x, w, b):
    xf = x.astype(jnp.float32)
    mu = jnp.mean(xf, axis=-1, keepdims=True)
    var = jnp.mean(jnp.square(xf - mu), axis=-1, keepdims=True)
    y = (xf - mu) * lax.rsqrt(var + EPS)
    return (y * w.astype(jnp.float32) + b.astype(jnp.float32)).astype(x.dtype)


def partial_rope(t, pos):
    tf = t.astype(jnp.float32)
    half = ROT_DIM // 2
    inv_freq = ROPE_THETA ** (-jnp.arange(0, ROT_DIM, 2, dtype=jnp.float32) / ROT_DIM)
    ang = pos.astype(jnp.float32)[:, None] * inv_freq[None, :]
    cos = jnp.cos(ang)[None, :, None, :]
    sin = jnp.sin(ang)[None, :, None, :]
    t1 = tf[..., :half]
    t2 = tf[..., half:ROT_DIM]
    rot = jnp.concatenate([t1 * cos - t2 * sin, t2 * cos + t1 * sin, tf[..., ROT_DIM:]], axis=-1)
    return rot.astype(t.dtype)


def s5_mixer(u, a_re, a_im, log_dt, b_re, b_im, c_re, c_im, d, glu_w, glu_b):
    bsz, L, _ = u.shape
    uf = u.astype(jnp.float32).reshape(bsz, L, SSM_GROUPS, SSM_GROUP)
    lam = lax.complex(a_re.astype(jnp.float32), a_im.astype(jnp.float32))
    dt = jnp.exp(log_dt.astype(jnp.float32))[:, None]
    lam_bar = jnp.exp(lam * dt)
    b = lax.complex(b_re.astype(jnp.float32), b_im.astype(jnp.float32))
    b_bar = ((lam_bar - 1.0) / lam)[..., None] * b
    bu = jnp.einsum('blgc,gpc->blgp', uf.astype(jnp.complex64), b_bar)
    a = jnp.broadcast_to(lam_bar, bu.shape)

    def combine(e1, e2):
        a1, b1 = e1
        a2, b2 = e2
        return a1 * a2, a2 * b1 + b2

    _, states = lax.associative_scan(combine, (a, bu), axis=1)
    c = lax.complex(c_re.astype(jnp.float32), c_im.astype(jnp.float32))
    y = jnp.real(jnp.einsum('blgp,gcp->blgc', states, c))
    y = y + d.astype(jnp.float32).reshape(SSM_GROUPS, SSM_GROUP) * uf
    y = jax.nn.gelu(y.reshape(bsz, L, SSM_WIDTH)).astype(u.dtype)
    return y * jax.nn.sigmoid(y @ glu_w + glu_b)


def spatial_gating(u, v, ln_w, ln_b, w_s, b_s):
    bsz, L, _ = u.shape
    n = L // SG_CHUNK
    v = layernorm(v, ln_w, ln_b)
    vc = v.reshape(bsz, n, SG_CHUNK, SG_HEADS, SG_HEAD_DIM)
    causal = jnp.tril(jnp.ones((SG_CHUNK, SG_CHUNK), dtype=bool))
    w = jnp.where(causal[None], w_s, jnp.zeros_like(w_s))
    mixed = jnp.einsum('hts,bnshc->bnthc', w, vc) + b_s.T[:, :, None]
    return u * mixed.reshape(bsz, L, SG_WIDTH)


def sliding_window_attention(q, k, v, sinks):
    bsz, L, _ = q.shape
    n = L // ATT_BLOCK
    pos = jnp.arange(L)
    q = partial_rope(q.reshape(bsz, L, ATT_HEADS, HEAD_DIM), pos)
    k = partial_rope(k.reshape(bsz, L, ATT_KV_HEADS, HEAD_DIM), pos)
    v = v.reshape(bsz, L, ATT_KV_HEADS, HEAD_DIM)

    def banded(t):
        tp = jnp.pad(t, ((0, 0), (ATT_BLOCK, 0), (0, 0), (0, 0)))
        prev = tp[:, :L].reshape(bsz, n, ATT_BLOCK, ATT_KV_HEADS, HEAD_DIM)
        cur = t.reshape(bsz, n, ATT_BLOCK, ATT_KV_HEADS, HEAD_DIM)
        return jnp.concatenate([prev, cur], axis=2)

    kb = banded(k)
    vb = banded(v)
    qb = q.reshape(bsz, n, ATT_BLOCK, ATT_KV_HEADS, GQA_GROUP, HEAD_DIM)
    s = jnp.einsum('bnqkgd,bnskd->bnkgqs', qb, kb).astype(jnp.float32) * (HEAD_DIM ** -0.5)
    blk = jnp.arange(n)[:, None, None]
    qpos = blk * ATT_BLOCK + jnp.arange(ATT_BLOCK)[None, :, None]
    kpos = (blk - 1) * ATT_BLOCK + jnp.arange(2 * ATT_BLOCK)[None, None, :]
    diff = qpos - kpos
    allowed = (diff >= 0) & (diff < WINDOW) & (kpos >= 0)
    s = jnp.where(allowed[None, :, None, None], s, NEG_INF)
    sink = sinks.astype(jnp.float32).reshape(ATT_KV_HEADS, GQA_GROUP)[None, None, :, :, None, None]
    sink = jnp.broadcast_to(sink, s.shape[:-1] + (1,))
    p = jax.nn.softmax(jnp.concatenate([s, sink], axis=-1), axis=-1)[..., :-1]
    o = jnp.einsum('bnkgqs,bnskd->bnqkgd', p.astype(vb.dtype), vb)
    return o.reshape(bsz, L, ATT_WIDTH)


def setup_inputs(seed: int = 0) -> dict:
    key = jax.random.key(seed)
    ks = jax.random.split(key, 24)
    f32 = jnp.float32
    nrm = lambda k, shape, scale: jax.random.normal(k, shape, f32) * scale
    G, P, C = SSM_GROUPS, SSM_STATE, SSM_GROUP
    x = jax.random.normal(ks[0], (BATCH, SEQ, D_MODEL), f32)
    norm_w = 1.0 + nrm(ks[1], (DEPTH, D_MODEL), 0.02)
    w_in = nrm(ks[2], (DEPTH, D_MODEL, D_IN), D_MODEL ** -0.5)
    ssm_a_re = -0.5 + nrm(ks[3], (DEPTH, G, P), 0.01)
    ssm_a_im = math.pi * jnp.arange(P, dtype=f32)[None, None, :] + nrm(ks[4], (DEPTH, G, P), 0.01)
    ssm_log_dt = jax.random.uniform(ks[5], (DEPTH, G), f32, math.log(DT_MIN), math.log(DT_MAX))
    ssm_b_re = nrm(ks[6], (DEPTH, G, P, C), C ** -0.5)
    ssm_b_im = nrm(ks[7], (DEPTH, G, P, C), C ** -0.5)
    ssm_c_re = nrm(ks[8], (DEPTH, G, C, P), P ** -0.5)
    ssm_c_im = nrm(ks[9], (DEPTH, G, C, P), P ** -0.5)
    ssm_d = nrm(ks[10], (DEPTH, SSM_WIDTH), 1.0)
    ssm_glu_w = nrm(ks[11], (DEPTH, SSM_WIDTH, SSM_WIDTH), SSM_WIDTH ** -0.5)
    ssm_glu_b = nrm(ks[12], (DEPTH, SSM_WIDTH), 0.01)
    sg_ln_w = 1.0 + nrm(ks[13], (DEPTH, SG_WIDTH), 0.02)
    sg_ln_b = nrm(ks[14], (DEPTH, SG_WIDTH), 0.02)
    sg_w = nrm(ks[15], (DEPTH, SG_HEADS, SG_CHUNK, SG_CHUNK), SG_CHUNK ** -0.5)
    sg_b = 1.0 + nrm(ks[16], (DEPTH, SG_HEADS, SG_CHUNK), 0.02)
    attn_sinks = nrm(ks[17], (DEPTH, ATT_HEADS), 1.0)
    w_branch_a = nrm(ks[18], (DEPTH, SSM_WIDTH, D_MODEL), SSM_WIDTH ** -0.5)
    w_branch_b = nrm(ks[19], (DEPTH, SG_WIDTH, D_MODEL), SG_WIDTH ** -0.5)
    w_branch_c = nrm(ks[20], (DEPTH, ATT_WIDTH, D_MODEL), ATT_WIDTH ** -0.5)
    w_out = nrm(ks[21], (DEPTH, D_MODEL, D_MODEL), D_MODEL ** -0.5)
    final_norm_w = 1.0 + nrm(ks[22], (D_MODEL,), 0.02)
    return {"x": x, "norm_w": norm_w, "w_in": w_in,
            "ssm_a_re": ssm_a_re, "ssm_a_im": ssm_a_im, "ssm_log_dt": ssm_log_dt,
            "ssm_b_re": ssm_b_re, "ssm_b_im": ssm_b_im, "ssm_c_re": ssm_c_re, "ssm_c_im": ssm_c_im,
            "ssm_d": ssm_d, "ssm_glu_w": ssm_glu_w, "ssm_glu_b": ssm_glu_b,
            "sg_ln_w": sg_ln_w, "sg_ln_b": sg_ln_b, "sg_w": sg_w, "sg_b": sg_b,
            "attn_sinks": attn_sinks,
            "w_branch_a": w_branch_a, "w_branch_b": w_branch_b, "w_branch_c": w_branch_c,
            "w_out": w_out, "final_norm_w": final_norm_w}


def reference(x, norm_w, w_in, ssm_a_re, ssm_a_im, ssm_log_dt, ssm_b_re, ssm_b_im,
              ssm_c_re, ssm_c_im, ssm_d, ssm_glu_w, ssm_glu_b, sg_ln_w, sg_ln_b, sg_w, sg_b,
              attn_sinks, w_branch_a, w_branch_b, w_branch_c, w_out, final_norm_w):
    bsz, L, _ = x.shape
    for l in range(DEPTH):
        h = rmsnorm(x, norm_w[l])
        proj = h @ w_in[l]
        u_a, z_a, u_b, v_b, z_b, q, k, v, z_c, gates = jnp.split(proj, IN_OFFSETS, axis=-1)
        y_a = s5_mixer(u_a, ssm_a_re[l], ssm_a_im[l], ssm_log_dt[l], ssm_b_re[l], ssm_b_im[l],
                       ssm_c_re[l], ssm_c_im[l], ssm_d[l], ssm_glu_w[l], ssm_glu_b[l]) * jax.nn.silu(z_a)
        y_b = spatial_gating(jax.nn.gelu(u_b), jax.nn.gelu(v_b), sg_ln_w[l], sg_ln_b[l],
                             sg_w[l], sg_b[l]) * jax.nn.silu(z_b)
        y_c = sliding_window_attention(q, k, v, attn_sinks[l]) * jax.nn.silu(z_c)
        g = jax.nn.sigmoid(gates.reshape(bsz, L, N_BRANCH, D_MODEL))
        merged = (g[:, :, 0] * (y_a @ w_branch_a[l])
                  + g[:, :, 1] * (y_b @ w_branch_b[l])
                  + g[:, :, 2] * (y_c @ w_branch_c[l]))
        x = x + merged @ w_out[l]
    return rmsnorm(x, final_norm_w)
```

```cpp
#include <hip/hip_runtime.h>
#include <hip/hip_cooperative_groups.h>
#include <cstdio>
#include <cstdint>
namespace cg = cooperative_groups;

#define LAS __attribute__((address_space(3)))
typedef unsigned short bf16_t;
typedef short bf16x8 __attribute__((ext_vector_type(8)));
typedef short s16x4 __attribute__((ext_vector_type(4)));
typedef float f32x4 __attribute__((ext_vector_type(4)));
typedef float f32x2 __attribute__((ext_vector_type(2)));
typedef unsigned u32x4 __attribute__((ext_vector_type(4)));
typedef unsigned u32x2 __attribute__((ext_vector_type(2)));

constexpr int NTOK = 8192, DM = 2048, DIN = 13568, SEQ = 2048;
constexpr int C_UA = 0, C_ZA = 1024, C_UB = 2048, C_VB = 3072, C_ZB = 4096, C_Q = 5120, C_K = 6144, C_V = 6272, C_ZC = 6400, C_G = 7424;
constexpr float EPS = 1e-6f;

constexpr size_t SZ_WIN = (size_t)DIN * DM * 2, SZ_GLU = (size_t)1024 * 1024 * 2, SZ_WBR = (size_t)2048 * 1024 * 2, SZ_WOUT = (size_t)2048 * 2048 * 2;
constexpr size_t SZ_KT = (size_t)64 * 65 * 512, SZ_E = (size_t)64 * 128 * 1024 * 2, SZ_F = SZ_E, SZ_L64 = (size_t)64 * 64 * 8;
constexpr size_t OFF_WIN = 0;
constexpr size_t OFF_GLU = OFF_WIN + 2 * SZ_WIN;
constexpr size_t OFF_WBR = OFF_GLU + 2 * SZ_GLU;
constexpr size_t OFF_WOUT = OFF_WBR + 6 * SZ_WBR;
constexpr size_t OFF_KT = OFF_WOUT + 2 * SZ_WOUT;
constexpr size_t OFF_E = OFF_KT + 2 * SZ_KT;
constexpr size_t OFF_F = OFF_E + 2 * SZ_E;
constexpr size_t OFF_L64 = OFF_F + 2 * SZ_F;
constexpr size_t OFF_ROPE = OFF_L64 + 2 * SZ_L64;
constexpr size_t OFF_XN = OFF_ROPE + (size_t)2048 * 16 * 4;
constexpr size_t OFF_X = OFF_XN + (size_t)NTOK * DM * 2;
constexpr size_t OFF_PROJ = OFF_X + (size_t)NTOK * DM * 4;
constexpr size_t OFF_YA0 = OFF_PROJ + (size_t)NTOK * DIN * 2;
constexpr size_t OFF_YA = OFF_YA0 + (size_t)NTOK * 1024 * 2;
constexpr size_t OFF_YB = OFF_YA + (size_t)NTOK * 1024 * 2;
constexpr size_t OFF_YC = OFF_YB + (size_t)NTOK * 1024 * 2;
constexpr size_t OFF_MG = OFF_YC + (size_t)NTOK * 1024 * 2;
constexpr size_t OFF_VBT = OFF_MG + (size_t)NTOK * DM * 2;
constexpr size_t OFF_VTT = OFF_VBT + (size_t)NTOK * 1024 * 2;
constexpr size_t OFF_ST = OFF_VTT + (size_t)8 * 64 * 2048 * 2;
constexpr size_t OFF_BAR = OFF_ST + (size_t)2 * NTOK * 2 * 4;
constexpr size_t OFF_SSQ = OFF_BAR + 16384;
constexpr size_t OFF_UA = OFF_SSQ + (size_t)2 * NTOK * 4;
constexpr size_t WS_END = OFF_UA + (size_t)NTOK * 1024 * 2;
static_assert(OFF_KT % 256 == 0 && OFF_E % 256 == 0 && OFF_XN % 256 == 0 && OFF_PROJ % 256 == 0 && OFF_YA0 % 256 == 0, "alignment");

constexpr int LDS_BYTES = 131072 + 64;

__device__ __forceinline__ int launder(int x) { asm volatile("" : "+v"(x)); return x; }
__device__ __forceinline__ unsigned f2bf(float f) { unsigned u = __builtin_bit_cast(unsigned, f); return (u + 0x7fffu + ((u >> 16) & 1u)) >> 16; }
__device__ __forceinline__ unsigned pk2(float lo, float hi) { return f2bf(lo) | (f2bf(hi) << 16); }
__device__ __forceinline__ unsigned cvt_pk_bf16(float lo, float hi) { unsigned r; asm volatile("v_cvt_pk_bf16_f32 %0, %1, %2" : "=v"(r) : "v"(lo), "v"(hi)); return r; }
__device__ __forceinline__ float bflo(unsigned u) { return __builtin_bit_cast(float, u << 16); }
__device__ __forceinline__ float bfhi(unsigned u) { return __builtin_bit_cast(float, u & 0xffff0000u); }
__device__ __forceinline__ float bf1(bf16_t h) { return __builtin_bit_cast(float, (unsigned)h << 16); }
__device__ __forceinline__ float sigm(float x) { return __builtin_amdgcn_rcpf(1.0f + __expf(-x)); }
__device__ __forceinline__ float silu_f(float x) { return x * sigm(x); }
__device__ __forceinline__ float gelu_f(float x) { return x * sigm(1.5957691216057308f * (x + 0.044715f * x * x * x)); }
__device__ __forceinline__ float wave_sum(float v) {
#pragma unroll
    for (int o = 1; o < 64; o <<= 1) v += __shfl_xor(v, o);
    return v;
}
__device__ __forceinline__ void unpack8(u32x4 w, float* f) { f[0] = bflo(w.x); f[1] = bfhi(w.x); f[2] = bflo(w.y); f[3] = bfhi(w.y); f[4] = bflo(w.z); f[5] = bfhi(w.z); f[6] = bflo(w.w); f[7] = bfhi(w.w); }
__device__ __forceinline__ void sincos_d(double x, double& s, double& c) {
    const double TWO_PI = 6.283185307179586476925;
    const double n = rint(x / TWO_PI);
    const double r = fma(-n, TWO_PI, x), r2 = r * r;
    double ts = r, tc = 1.0; s = r; c = 1.0;
    _Pragma("unroll") for (int k = 1; k <= 18; ++k) { tc *= -r2 * (1.0 / (double)((2 * k - 1) * (2 * k))); c += tc; ts *= -r2 * (1.0 / (double)((2 * k) * (2 * k + 1))); s += ts; }
}
__device__ __forceinline__ double exp_d(double x) {
    const double LN2 = 0.693147180559945309417;
    const double n = rint(x / LN2);
    const double r = fma(-n, LN2, x);
    double t = 1.0, s = 1.0;
    _Pragma("unroll") for (int k = 1; k <= 16; ++k) { t *= r * (1.0 / (double)k); s += t; }
    return ldexp(s, (int)n);
}
#define XB_TMO      128
#define XB_XCNT(j)  (256  + 64 * (j))
#define XB_XSUB(j)  (1280 + 64 * (j))
#define XB_XGEN(j)  (2304 + 64 * (j))
#define XB_TOP      3328
#define XB_TOPGEN   3392
#define XCD_BAR_WORDS 3456
#define XB_SPIN_CAP (1u << 18)

__device__ __forceinline__ unsigned xb_ld(unsigned* p)              { return __hip_atomic_load(p, __ATOMIC_RELAXED, __HIP_MEMORY_SCOPE_AGENT); }
__device__ __forceinline__ unsigned xb_add(unsigned* p, unsigned v) { return __hip_atomic_fetch_add(p, v, __ATOMIC_RELAXED, __HIP_MEMORY_SCOPE_AGENT); }
__device__ __forceinline__ unsigned xb_xcc_id() { return (unsigned)__builtin_amdgcn_s_getreg((3 << 11) | 20) & 0xFu; }
#define XB_SPIN(cond, bar) do { unsigned _sp = 0; while (cond) { __builtin_amdgcn_s_sleep(1); \
    if ((++_sp & 255u) == 0u) { if (xb_ld(&(bar)[XB_TMO])) break; if (_sp > XB_SPIN_CAP) { atomicAdd(&(bar)[XB_TMO], 1u); break; } } } } while (0)

struct XcdBarrier {
    unsigned* bar; unsigned x;
    volatile LAS unsigned* st;
};

__device__ __forceinline__ XcdBarrier xcd_barrier_post(unsigned* bar, volatile LAS unsigned* st) {
    XcdBarrier b; b.bar = bar; b.x = xb_xcc_id(); b.st = st;
    if (threadIdx.x == 0) (void)xb_add(&bar[XB_XCNT(b.x)], 1u);
    return b;
}
__device__ __forceinline__ void xcd_barrier_complete(unsigned* bar, unsigned x, unsigned& nloc, unsigned& nx) {
    const unsigned G = gridDim.x * gridDim.y * gridDim.z;
    unsigned sum, cnt, mine, sp = 0u;
    for (;;) {
        sum = 0u; cnt = 0u; mine = 0u;
#pragma unroll
        for (unsigned j = 0; j < 16; ++j) { const unsigned c = xb_ld(&bar[XB_XCNT(j)]); sum += c; cnt += (c > 0u) ? 1u : 0u; mine = (j == x) ? c : mine; }
        if (sum == G) break;
        __builtin_amdgcn_s_sleep(1);
        if ((++sp & 255u) == 0u) { if (xb_ld(&bar[XB_TMO])) break; if (sp > XB_SPIN_CAP) { atomicAdd(&bar[XB_TMO], 1u); break; } }
    }
    nloc = mine > 0u ? mine : 1u; nx = cnt > 0u ? cnt : 1u;
}

__device__ __forceinline__ void xcd_barrier(const XcdBarrier& b) {
    asm volatile("s_waitcnt vmcnt(0)" ::: "memory");
    __syncthreads();
    if (threadIdx.x == 0) {
        unsigned* bar = b.bar;
        __builtin_amdgcn_s_waitcnt(0);
        unsigned nloc = b.st[0], nx = b.st[1];
        if (nloc == 0u) { xcd_barrier_complete(bar, b.x, nloc, nx); b.st[0] = nloc; b.st[1] = nx; }
        const unsigned old = xb_add(&bar[XB_XSUB(b.x)], 1u);
        const unsigned gen = old / nloc;
        if (old + 1u == (gen + 1u) * nloc) {
            __builtin_amdgcn_fence(__ATOMIC_RELEASE, "agent");
            asm volatile("s_waitcnt vmcnt(0)" ::: "memory");
            const unsigned og = xb_add(&bar[XB_TOP], 1u);
            const unsigned tg = og / nx;
            if (og + 1u == (tg + 1u) * nx) xb_add(&bar[XB_TOPGEN], 1u);
            else XB_SPIN(xb_ld(&bar[XB_TOPGEN]) == tg, bar);
            __builtin_amdgcn_fence(__ATOMIC_ACQUIRE, "agent");
            xb_add(&bar[XB_XGEN(b.x)], 1u);
            asm volatile("s_waitcnt vmcnt(0)" ::: "memory");
        } else {
            XB_SPIN(xb_ld(&bar[XB_XGEN(b.x)]) == gen, bar);
            __builtin_amdgcn_fence(__ATOMIC_ACQUIRE, "agent");
            asm volatile("s_waitcnt vmcnt(0)" ::: "memory");
        }
    }
    __syncthreads();
}

namespace pg8 {
#define PG8_LAS __attribute__((address_space(3)))
constexpr int BM = 256, BK = 64, HALF = 128, HTB = HALF * BK * 2, STAGE_BYTES = 8 * HTB, NXCD = 8, WGM = 4;
__device__ __forceinline__ int lds_byte(int r, int c) { const int st = (r >> 4) * 2 + (c >> 5), rr = r & 15, cc = c & 31, ob = rr * 64 + cc * 2; return st * 1024 + (ob ^ (((ob >> 9) & 1) << 5)); }
__device__ __forceinline__ void stage_rc(int b, int& R, int& C) { const int st = b / 1024, sb = b % 1024, swz = sb ^ (((sb >> 9) & 1) << 5); R = (st >> 1) * 16 + swz / 64; C = (st & 1) * 32 + (swz % 64) / 2; }
__device__ __forceinline__ int perm32(int rho) { const int n = rho >> 4, i = rho & 15; return 8 * (i >> 2) + 4 * n + (i & 3); }

struct Unit { int pm, pn, seg; };
struct Gemm { const bf16_t* A0; const bf16_t* A1; const bf16_t* A2; const bf16_t* B0; const bf16_t* B1; const bf16_t* B2; int M, N, K; };
struct Order {
    int nM, nN, nwg, G, c, nseg, rot;
    __device__ __forceinline__ void init(int M, int N, int G_, int c_, int nseg_) { nM = M / BM; nN = N / BM; nwg = nM * nN; G = G_; c = c_; nseg = nseg_; rot = 0; }
    __device__ __forceinline__ bool next(int i, Unit& u) const {
        const int ti = (nseg == 1) ? i : i / 3; u.seg = (nseg == 1) ? 0 : i - 3 * ti;
        const long L = (long)ti * G + c; if (L >= nwg) return false;
        int wgid = (int)L; { const int q = nwg / NXCD, r = nwg % NXCD, xcd = wgid % NXCD, off = wgid / NXCD; wgid = (xcd < r ? xcd * (q + 1) : r * (q + 1) + (xcd - r) * q) + off; }
        const int nig = WGM * nN, gid = wgid / nig, fm = gid * WGM, gsz = (nM - fm) < WGM ? (nM - fm) : WGM;
        u.pm = fm + ((wgid % nig) % gsz); int pn = (wgid % nig) / gsz;
        if (rot != 0 && (nwg % NXCD) == 0 && ((nwg / NXCD) % nig) == 0 && (nM % WGM) == 0) pn = (pn + rot * (wgid / (nwg / NXCD))) % nN;
        u.pn = pn; return true;
    }
};
template <class Epi>
__device__ __forceinline__ void gemm_phase(PG8_LAS unsigned char* lds, const Gemm g, const Order& S, const Epi& E) {
    const int tid = launder((int)threadIdx.x), wid = __builtin_amdgcn_readfirstlane(tid >> 6), lane = tid & 63, wr = wid >> 2, wc = wid & 3, fr = lane & 15, fq = lane >> 4;
    const int K = g.K, nt = K / BK;
    unsigned voffA[2], voffB[2];
#pragma unroll
    for (int i = 0; i < 2; ++i) { int R, C; stage_rc(tid * 16 + i * 8192, R, C); const int Rb = (R & ~31) + perm32(R & 31);
        voffA[i] = (unsigned)(R * K + C) * 2u; voffB[i] = (unsigned)(Rb * K + C) * 2u; }
    const size_t kstep = (size_t)(BK * 2);
    const size_t hstep = (size_t)HALF * K * 2;
    const size_t tstep = 2 * hstep;
    const unsigned ldsw = (unsigned)wid * 1024u;
    const int aoff = lds_byte(wr * 64 + fr, fq * 8), boff = lds_byte(wc * 32 + fr, fq * 8);
#define PG8_SA(b, h) (((b) * 2 + (h)) * HTB)
#define PG8_SB(b, h) ((4 + (b) * 2 + (h)) * HTB)
#define PG8_STAGE(bufoff, gbase, voff) do { _Pragma("unroll") for (int _i = 0; _i < 2; ++_i) \
        __builtin_amdgcn_global_load_lds((const unsigned*)((const char*)(gbase) + (voff)[_i]), (PG8_LAS unsigned*)(lds + (bufoff) + ldsw + _i * 8192), 16, 0, 0); } while (0)
#define PG8_LDA(dst, b, h) do { _Pragma("unroll") for (int m = 0; m < 4; ++m) _Pragma("unroll") for (int k = 0; k < 2; ++k) dst[m][k] = *(const PG8_LAS bf16x8*)(lds + PG8_SA(b, h) + aoff + m * 2048 + k * 1024); } while (0)
#define PG8_LDB(dst, b, h) do { _Pragma("unroll") for (int n = 0; n < 2; ++n) _Pragma("unroll") for (int k = 0; k < 2; ++k) dst[n][k] = *(const PG8_LAS bf16x8*)(lds + PG8_SB(b, h) + boff + n * 2048 + k * 1024); } while (0)
#define PG8_MMA(ai, bj, At, Bt) do { __builtin_amdgcn_s_setprio(1); _Pragma("unroll") for (int m = 0; m < 4; ++m) _Pragma("unroll") for (int n = 0; n < 2; ++n) _Pragma("unroll") for (int k = 0; k < 2; ++k) \
        acc[ai][bj][m][n] = __builtin_amdgcn_mfma_f32_16x16x32_bf16(Bt[n][k], At[m][k], acc[ai][bj][m][n], 0, 0, 0); __builtin_amdgcn_s_setprio(0); } while (0)
#define PG8_WAIT_V(n) asm volatile("s_waitcnt vmcnt(" #n ")" ::: "memory")
#define PG8_WAIT_L(n) asm volatile("s_waitcnt lgkmcnt(" #n ")" ::: "memory")
#define PG8_BAR __builtin_amdgcn_s_barrier()
#define PG8_SCHED __builtin_amdgcn_sched_barrier(0)
#define PG8_APTR(u) ((const char*)((u).seg == 0 ? g.A0 : ((u).seg == 1 ? g.A1 : g.A2)) + (size_t)(u).pm * tstep)
#define PG8_BPTR(u) ((const char*)((u).seg == 0 ? g.B0 : ((u).seg == 1 ? g.B1 : g.B2)) + (size_t)(u).pn * tstep)
    Unit cur, nxt; int ui = 0;
    if (!S.next(0, cur)) return;
    f32x4 acc[2][2][4][2];
#pragma unroll
    for (int a = 0; a < 2; ++a)
#pragma unroll
        for (int b = 0; b < 2; ++b)
#pragma unroll
            for (int m = 0; m < 4; ++m)
#pragma unroll
                for (int n = 0; n < 2; ++n) acc[a][b][m][n] = (f32x4){0.f, 0.f, 0.f, 0.f};
    bf16x8 At[4][2], B0[2][2], B1[2][2];
    const char* cA = PG8_APTR(cur); const char* cB = PG8_BPTR(cur);
    PG8_STAGE(PG8_SB(0, 0), cB, voffB); PG8_STAGE(PG8_SB(0, 1), cB + hstep, voffB); PG8_STAGE(PG8_SA(0, 0), cA, voffA); PG8_STAGE(PG8_SA(0, 1), cA + hstep, voffA);
    if (wr == 1) PG8_BAR;
    PG8_WAIT_V(2); PG8_BAR;
    PG8_STAGE(PG8_SB(1, 0), cB + kstep, voffB); PG8_STAGE(PG8_SA(1, 0), cA + kstep, voffA); PG8_STAGE(PG8_SB(1, 1), cB + hstep + kstep, voffB);
    PG8_WAIT_V(6); PG8_BAR;
    for (;;) {
        const bool has_next = S.next(ui + 1, nxt);
        const char* nA = has_next ? PG8_APTR(nxt) : cA; const char* nB = has_next ? PG8_BPTR(nxt) : cB;
        for (int t = 0; t < nt; t += 2) {
            const bool last = (t == nt - 2);
            const char* a1 = cA + (size_t)(t + 1) * kstep;
            const char* a2 = last ? nA : cA + (size_t)(t + 2) * kstep; const char* b2 = last ? nB : cB + (size_t)(t + 2) * kstep;
            const char* a3 = a2 + kstep; const char* b3 = b2 + kstep;
            PG8_LDB(B0, 0, 0); PG8_LDB(B1, 0, 1); PG8_SCHED; PG8_LDA(At, 0, 0); PG8_STAGE(PG8_SA(1, 1), a1 + hstep, voffA);
            PG8_WAIT_V(8); PG8_WAIT_L(0); PG8_BAR; PG8_MMA(0, 0, At, B0); PG8_MMA(0, 1, At, B1); PG8_BAR; PG8_SCHED;
            PG8_LDA(At, 0, 1); PG8_STAGE(PG8_SB(0, 0), b2, voffB); PG8_STAGE(PG8_SB(0, 1), b2 + hstep, voffB); PG8_STAGE(PG8_SA(0, 0), a2, voffA);
            PG8_WAIT_V(8); PG8_WAIT_L(0); PG8_BAR; PG8_MMA(1, 0, At, B0); PG8_MMA(1, 1, At, B1); PG8_BAR; PG8_SCHED;
            PG8_LDB(B0, 1, 0); PG8_LDB(B1, 1, 1); PG8_SCHED; PG8_LDA(At, 1, 0); PG8_STAGE(PG8_SA(0, 1), a2 + hstep, voffA);
            PG8_WAIT_V(8); PG8_WAIT_L(0); PG8_BAR; PG8_MMA(0, 0, At, B0); PG8_MMA(0, 1, At, B1); PG8_BAR; PG8_SCHED;
            PG8_LDA(At, 1, 1); PG8_STAGE(PG8_SB(1, 0), b3, voffB); PG8_STAGE(PG8_SB(1, 1), b3 + hstep, voffB); PG8_STAGE(PG8_SA(1, 0), a3, voffA);
            PG8_WAIT_V(8); PG8_WAIT_L(0); PG8_BAR; PG8_MMA(1, 0, At, B0); PG8_MMA(1, 1, At, B1); PG8_BAR; PG8_SCHED;
        }
        if (wr == 0) PG8_BAR;
        const bool rst = E.apply(acc, cur, wr, wc, fr, fq);
        if (!has_next) break;
        if (rst) {
#pragma unroll
        for (int a = 0; a < 2; ++a)
#pragma unroll
            for (int b = 0; b < 2; ++b)
#pragma unroll
                for (int m = 0; m < 4; ++m)
#pragma unroll
                    for (int n = 0; n < 2; ++n) acc[a][b][m][n] = (f32x4){0.f, 0.f, 0.f, 0.f};
        }
        cur = nxt; cA = nA; cB = nB; ++ui;
        if (wr == 1) PG8_BAR;
    }
    PG8_WAIT_V(0);
    PG8_BAR;
#undef PG8_SA
#undef PG8_SB
#undef PG8_STAGE
#undef PG8_LDA
#undef PG8_LDB
#undef PG8_MMA
#undef PG8_WAIT_V
#undef PG8_WAIT_L
#undef PG8_BAR
#undef PG8_SCHED
#undef PG8_APTR
#undef PG8_BPTR
}
}
#define EPI_LOOP_BEGIN \
    _Pragma("unroll") for (int ai = 0; ai < 2; ++ai) _Pragma("unroll") for (int m = 0; m < 4; ++m) { \
        const int row = u.pm * 256 + ai * 128 + wr * 64 + m * 16 + fr; \
        _Pragma("unroll") for (int bj = 0; bj < 2; ++bj) { const int col = u.pn * 256 + bj * 128 + wc * 32 + 8 * fq; \
            f32x4 v0 = acc[ai][bj][m][0], v1 = acc[ai][bj][m][1];
#define EPI_LOOP_END } }

struct EpiProj {
    bf16_t* O; bf16_t* VBT; bf16_t* VTT; float* ST; const float* rope; int pn_off; const float* ssq; bf16_t* UA;
    __device__ __forceinline__ bool apply(f32x4 (&acc)[2][2][4][2], const pg8::Unit& u, int wr, int wc, int fr, int fq) const {
        const int pn = u.pn + pn_off;
        const int act = (pn < 4) ? 0 : (pn < 8) ? 1 : (pn < 16) ? 2 : (pn < 20) ? 1 : (pn < 25) ? 0 : (pn < 29) ? 1 : 3;
        const bool is_vb = (pn >= 12) && (pn < 16), is_q = (pn >= 20) && (pn < 24), is_kv = (pn == 24);
        const bool rot_lane = ((wc & 1) == 0) && (fq < 2);
        const float sg = (fq == 0) ? -1.f : 1.f;
#pragma unroll
        for (int ai = 0; ai < 2; ++ai)
#pragma unroll
            for (int m = 0; m < 4; ++m) {
                const int row = u.pm * 256 + ai * 128 + wr * 64 + m * 16 + fr;
                const float nrm = 1.0f / sqrtf(ssq[row] * (1.0f / DM) + EPS);
                float rs = 0.f, rss = 0.f;
#pragma unroll
                for (int bj = 0; bj < 2; ++bj) {
                    const int col = pn * 256 + bj * 128 + wc * 32 + 8 * fq;
                    const f32x4 v0 = acc[ai][bj][m][0], v1 = acc[ai][bj][m][1];
                    float f[8] = {v0[0] * nrm, v0[1] * nrm, v0[2] * nrm, v0[3] * nrm, v1[0] * nrm, v1[1] * nrm, v1[2] * nrm, v1[3] * nrm};
                    if (act == 1) { _Pragma("unroll") for (int e = 0; e < 8; ++e) f[e] = silu_f(f[e]); }
                    else if (act == 2) { _Pragma("unroll") for (int e = 0; e < 8; ++e) f[e] = gelu_f(f[e]); }
                    else if (act == 3) { _Pragma("unroll") for (int e = 0; e < 8; ++e) f[e] = sigm(f[e]); }
                    if (is_q || (is_kv && bj == 0)) {
                        float o[8];
                        _Pragma("unroll") for (int e = 0; e < 8; ++e) o[e] = __shfl_xor(f[e], 16);
                        if (rot_lane) { const f32x4* rp = (const f32x4*)(rope + (row & 2047) * 16);
                            const f32x4 c0 = rp[0], c1 = rp[1], c2 = rp[2], c3 = rp[3];
                            const float cs[16] = {c0[0], c0[1], c0[2], c0[3], c1[0], c1[1], c1[2], c1[3], c2[0], c2[1], c2[2], c2[3], c3[0], c3[1], c3[2], c3[3]};
                            _Pragma("unroll") for (int e = 0; e < 8; ++e) f[e] = f[e] * cs[2 * e] + sg * o[e] * cs[2 * e + 1]; }
                        if (is_q) { _Pragma("unroll") for (int e = 0; e < 8; ++e) f[e] *= 0.125f; }
                    }
                    if (is_vb) {
                        _Pragma("unroll") for (int e = 0; e < 8; ++e) { rs += f[e]; rss += f[e] * f[e]; }
                        bf16_t* dst = VBT + ((size_t)(row >> 7) * 1024 + (col - C_VB)) * 128 + (row & 127);
                        _Pragma("unroll") for (int e = 0; e < 8; ++e) dst[e * 128] = (bf16_t)f2bf(f[e]);
                    } else if (is_kv && bj == 1) {
                        bf16_t* dst = VTT + ((size_t)((row >> 11) * 2 + (wc >> 1)) * 64 + (wc & 1) * 32 + 8 * fq) * 2048 + (row & 2047);
                        _Pragma("unroll") for (int e = 0; e < 8; ++e) dst[e * 2048] = (bf16_t)f2bf(f[e]);
                    } else {
                        u32x4 w; w.x = cvt_pk_bf16(f[0], f[1]); w.y = cvt_pk_bf16(f[2], f[3]); w.z = cvt_pk_bf16(f[4], f[5]); w.w = cvt_pk_bf16(f[6], f[7]);
                        if (pn < 4) *(u32x4*)(UA + ((size_t)(col >> 4) * NTOK + row) * 16 + (col & 15)) = w;
                        else __builtin_nontemporal_store(w, (u32x4*)(O + (size_t)row * DIN + col));
                    }
                }
                if (is_vb) {
                    rs += __shfl_xor(rs, 16); rs += __shfl_xor(rs, 32); rss += __shfl_xor(rss, 16); rss += __shfl_xor(rss, 32);
                    if (fq == 0) { unsafeAtomicAdd(ST + row * 2, rs); unsafeAtomicAdd(ST + row * 2 + 1, rss); }
                }
            }
        return true;
    }
};
struct EpiGlu {
    const float* bias; const bf16_t* ya0; const bf16_t* proj; bf16_t* O;
    __device__ __forceinline__ bool apply(f32x4 (&acc)[2][2][4][2], const pg8::Unit& u, int wr, int wc, int fr, int fq) const {
        EPI_LOOP_BEGIN
            const f32x4 b0 = *(const f32x4*)(bias + col), b1 = *(const f32x4*)(bias + col + 4);
            float f[8] = {v0[0] + b0[0], v0[1] + b0[1], v0[2] + b0[2], v0[3] + b0[3], v1[0] + b1[0], v1[1] + b1[1], v1[2] + b1[2], v1[3] + b1[3]};
            float y[8], z[8];
            unpack8(*(const u32x4*)(ya0 + (size_t)row * 1024 + col), y);
            unpack8(*(const u32x4*)(proj + (size_t)row * DIN + C_ZA + col), z);
            _Pragma("unroll") for (int e = 0; e < 8; ++e) f[e] = y[e] * sigm(f[e]) * z[e];
            u32x4 w; w.x = cvt_pk_bf16(f[0], f[1]); w.y = cvt_pk_bf16(f[2], f[3]); w.z = cvt_pk_bf16(f[4], f[5]); w.w = cvt_pk_bf16(f[6], f[7]);
            *(u32x4*)(O + (size_t)row * 1024 + col) = w;
        EPI_LOOP_END
        return true;
    }
};
struct EpiMerge {
    const bf16_t* proj; bf16_t* O;
    __device__ __forceinline__ bool apply(f32x4 (&acc)[2][2][4][2], const pg8::Unit& u, int wr, int wc, int fr, int fq) const {
        const int seg = u.seg;
        EPI_LOOP_BEGIN
            float f[8] = {v0[0], v0[1], v0[2], v0[3], v1[0], v1[1], v1[2], v1[3]};
            const bf16_t* gp = proj + (size_t)row * DIN + C_G + col;
            if (seg < 2) {
                float gn[8], gd[8];
                unpack8(*(const u32x4*)(gp + seg * 2048), gn);
                unpack8(*(const u32x4*)(gp + (seg + 1) * 2048), gd);
                _Pragma("unroll") for (int e = 0; e < 8; ++e) f[e] = f[e] * (gn[e] * __builtin_amdgcn_rcpf(fmaxf(gd[e], 1e-30f)));
                acc[ai][bj][m][0] = (f32x4){f[0], f[1], f[2], f[3]}; acc[ai][bj][m][1] = (f32x4){f[4], f[5], f[6], f[7]};
            } else {
                float gn[8];
                unpack8(*(const u32x4*)(gp + 2 * 2048), gn);
                _Pragma("unroll") for (int e = 0; e < 8; ++e) f[e] = f[e] * gn[e];
                u32x4 w; w.x = cvt_pk_bf16(f[0], f[1]); w.y = cvt_pk_bf16(f[2], f[3]); w.z = cvt_pk_bf16(f[4], f[5]); w.w = cvt_pk_bf16(f[6], f[7]);
                *(u32x4*)(O + (size_t)row * DM + col) = w;
            }
        EPI_LOOP_END
        return seg == 2;
    }
};
struct EpiOut {
    const float* xin; float* xout; bf16_t* xn; const float* wn; float* ssq;
    __device__ __forceinline__ bool apply(f32x4 (&acc)[2][2][4][2], const pg8::Unit& u, int wr, int wc, int fr, int fq) const {
#pragma unroll
        for (int ai = 0; ai < 2; ++ai)
#pragma unroll
            for (int m = 0; m < 4; ++m) {
                const int row = u.pm * 256 + ai * 128 + wr * 64 + m * 16 + fr;
                float q = 0.f;
#pragma unroll
                for (int bj = 0; bj < 2; ++bj) {
                    const int col = u.pn * 256 + bj * 128 + wc * 32 + 8 * fq;
                    const size_t o = (size_t)row * DM + col;
                    const f32x4 x0 = *(const f32x4*)(xin + o) + acc[ai][bj][m][0], x1 = *(const f32x4*)(xin + o + 4) + acc[ai][bj][m][1];
                    *(f32x4*)(xout + o) = x0; *(f32x4*)(xout + o + 4) = x1;
                    if (xn) {
                        const f32x4 w0 = *(const f32x4*)(wn + col), w1 = *(const f32x4*)(wn + col + 4);
                        q += (x0[0] * x0[0] + x0[1] * x0[1]) + (x0[2] * x0[2] + x0[3] * x0[3]) + (x1[0] * x1[0] + x1[1] * x1[1]) + (x1[2] * x1[2] + x1[3] * x1[3]);
                        u32x4 w; w.x = cvt_pk_bf16(x0[0] * w0[0], x0[1] * w0[1]); w.y = cvt_pk_bf16(x0[2] * w0[2], x0[3] * w0[3]);
                        w.z = cvt_pk_bf16(x1[0] * w1[0], x1[1] * w1[1]); w.w = cvt_pk_bf16(x1[2] * w1[2], x1[3] * w1[3]);
                        *(u32x4*)(xn + o) = w;
                    }
                }
                if (xn) { q += __shfl_xor(q, 16); q += __shfl_xor(q, 32); if (fq == 0) unsafeAtomicAdd(ssq + row, q); }
            }
        return true;
    }
};
struct KParams { const float* in[23]; float* out; unsigned char* ws; };

__device__ __forceinline__ void p0_transpose_item(const float* W, int K, int N, bf16_t* WT, LAS unsigned char* scr, int item, int lane) {
    const int nblk = N / 64, kb = item / nblk, nb = item - kb * nblk, k0 = 64 * kb, n0 = 64 * nb;
    f32x4 v[16];
    const float* src = W + (size_t)(k0 + (lane >> 4)) * N + n0 + 4 * (lane & 15);
#pragma unroll
    for (int i = 0; i < 16; ++i) v[i] = __builtin_nontemporal_load((const f32x4*)(src + (size_t)(4 * i) * N));
#pragma unroll
    for (int i = 0; i < 16; ++i) { const int kk = (lane >> 4) + 4 * i; LAS bf16_t* d = (LAS bf16_t*)scr + (4 * (lane & 15)) * 66 + kk;
        d[0] = (bf16_t)f2bf(v[i][0]); d[66] = (bf16_t)f2bf(v[i][1]); d[132] = (bf16_t)f2bf(v[i][2]); d[198] = (bf16_t)f2bf(v[i][3]); }
    asm volatile("s_waitcnt lgkmcnt(0)" ::: "memory");
    const int c = lane & 7;
#pragma unroll
    for (int j = 0; j < 8; ++j) { const int n = (lane >> 3) + 8 * j; const LAS unsigned* s = (const LAS unsigned*)(scr + n * 132 + c * 16);
        u32x4 o; o.x = s[0]; o.y = s[1]; o.z = s[2]; o.w = s[3];
        *(u32x4*)(WT + (size_t)(n0 + n) * K + k0 + 8 * c) = o; }
    asm volatile("s_waitcnt lgkmcnt(0)" ::: "memory");
}
__device__ __forceinline__ void xw_row_bf16(const float* xrow, const float* w, bf16_t* orow, float* ssq_out, int lane) {
    const f32x4* xr = (const f32x4*)xrow + lane; const f32x4* wr = (const f32x4*)w + lane;
    f32x4 v[8]; float s = 0.f;
#pragma unroll
    for (int j = 0; j < 8; ++j) { v[j] = xr[64 * j]; s += (v[j].x * v[j].x + v[j].y * v[j].y) + (v[j].z * v[j].z + v[j].w * v[j].w); }
    s = wave_sum(s);
    if (lane == 0) *ssq_out = s;
    u32x2* o8 = (u32x2*)orow + lane;
#pragma unroll
    for (int j = 0; j < 8; ++j) { const f32x4 ww = wr[64 * j]; u32x2 o; o.x = pk2(v[j].x * ww.x, v[j].y * ww.y); o.y = pk2(v[j].z * ww.z, v[j].w * ww.w); o8[64 * j] = o; }
}
__device__ __forceinline__ void rms_row_f32(const float* xrow, const float* w, float* orow, int lane) {
    const f32x4* xr = (const f32x4*)xrow + lane; const f32x4* wr = (const f32x4*)w + lane;
    f32x4 v[8]; float s = 0.f;
#pragma unroll
    for (int j = 0; j < 8; ++j) { v[j] = xr[64 * j]; s += (v[j].x * v[j].x + v[j].y * v[j].y) + (v[j].z * v[j].z + v[j].w * v[j].w); }
    const float rs = 1.0f / sqrtf(wave_sum(s) * (1.0f / DM) + EPS);
    f32x4* o = (f32x4*)orow + lane;
#pragma unroll
    for (int j = 0; j < 8; ++j) { const f32x4 ww = wr[64 * j]; __builtin_nontemporal_store(v[j] * rs * ww, o + 64 * j); }
}

__device__ __forceinline__ void s5_tables_item(const KParams& P, LAS unsigned char* lds, int l, int g) {
    const int tid = launder((int)threadIdx.x);
    LAS float* LPre = (LAS float*)lds; LAS float* LPim = LPre + 64 * 68; LAS float* LTre = LPim + 64 * 68; LAS float* LTim = LTre + 65 * 64;
    LAS float* BBre = LTim + 65 * 64; LAS float* BBim = BBre + 1024; LAS float* CCre = BBim + 1024; LAS float* CCim = CCre + 1024;
    const float* a_re = P.in[3] + (size_t)(l * 64 + g) * 64; const float* a_im = P.in[4] + (size_t)(l * 64 + g) * 64;
    const float* b_re = P.in[6] + (size_t)(l * 64 + g) * 1024; const float* b_im = P.in[7] + (size_t)(l * 64 + g) * 1024;
    const float* c_re = P.in[8] + (size_t)(l * 64 + g) * 1024; const float* c_im = P.in[9] + (size_t)(l * 64 + g) * 1024;
    bf16_t* KT = (bf16_t*)(P.ws + OFF_KT + (size_t)l * SZ_KT) + (size_t)g * 65 * 256;
    bf16_t* Eg = (bf16_t*)(P.ws + OFF_E + (size_t)l * SZ_E) + (size_t)g * 128 * 1024;
    bf16_t* Fg = (bf16_t*)(P.ws + OFF_F + (size_t)l * SZ_F) + (size_t)g * 1024 * 128;
    float* L64 = (float*)(P.ws + OFF_L64 + (size_t)l * SZ_L64) + (size_t)g * 128;
    if (tid < 64) {
        const int p = tid;
        const double dt = exp_d((double)P.in[5][l * 64 + g]);
        const double are = (double)a_re[p], aim = (double)a_im[p];
        const double zr = are * dt, zi = aim * dt;
        double sn, cs; sincos_d(zi, sn, cs);
        const double ez = exp_d(zr);
        const double lbr = ez * cs, lbi = ez * sn;
        double qr, qi;
        if (zr * zr + zi * zi < 0.25) {
            double tr = 1.0, ti = 0.0; qr = 1.0; qi = 0.0;
#pragma unroll
            for (int k = 1; k <= 20; ++k) { const double rk = 1.0 / (double)(k + 1); const double nr = (tr * zr - ti * zi) * rk, ni = (tr * zi + ti * zr) * rk; tr = nr; ti = ni; qr += tr; qi += ti; }
        } else {
            const double nr = lbr - 1.0, ni = lbi, den = 1.0 / (zr * zr + zi * zi);
            qr = (nr * zr + ni * zi) * den; qi = (ni * zr - nr * zi) * den;
        }
        const double cr = qr * dt, ci = qi * dt;
#pragma unroll 4
        for (int c = 0; c < 16; ++c) { const double br = (double)b_re[p * 16 + c], bi = (double)b_im[p * 16 + c];
            BBre[p * 16 + c] = (float)(cr * br - ci * bi); BBim[p * 16 + c] = (float)(cr * bi + ci * br); }
        double pr = 1.0, pi = 0.0;
        for (int k = 0; k <= 64; ++k) { const float fr_ = (float)pr, fi_ = (float)pi; LPre[p * 68 + k] = fr_; LPim[p * 68 + k] = fi_; LTre[k * 64 + p] = fr_; LTim[k * 64 + p] = fi_;
            if (k == 64) { L64[p * 2 + 0] = fr_; L64[p * 2 + 1] = fi_; }
            const double nr = pr * lbr - pi * lbi, ni = pr * lbi + pi * lbr; pr = nr; pi = ni; }
    }
    for (int i = tid; i < 1024; i += 512) { CCre[i] = c_re[i]; CCim[i] = c_im[i]; }
    __syncthreads();
    {
        const int pair = tid & 255, c = pair >> 4, cp = pair & 15, half = tid >> 8;
        f32x4 a[8];
#pragma unroll
        for (int i = 0; i < 8; ++i) a[i] = (f32x4){0.f, 0.f, 0.f, 0.f};
#pragma unroll 2
        for (int p = 0; p < 64; ++p) {
            const float xr = CCre[c * 64 + p], xi = CCim[c * 64 + p], yr = BBre[p * 16 + cp], yi = BBim[p * 16 + cp];
            const float cbr = xr * yr - xi * yi, cbi = xr * yi + xi * yr;
#pragma unroll
            for (int i = 0; i < 8; ++i) { const f32x4 lr = *(LAS f32x4*)(LPre + p * 68 + half * 32 + 4 * i), li = *(LAS f32x4*)(LPim + p * 68 + half * 32 + 4 * i); a[i] += cbr * lr - cbi * li; }
        }
#pragma unroll
        for (int i = 0; i < 32; ++i) KT[(size_t)(half * 32 + i + 1) * 256 + pair] = (bf16_t)f2bf(a[i >> 2][i & 3]);
        if (tid < 256) KT[tid] = 0;
    }
    for (int j = 0; j < 16; ++j) {
        const int id = tid + 512 * j, pp = id >> 6, s = id & 63, p = pp & 63, ri = pp >> 6;
        const float lr = LPre[p * 68 + 63 - s], li = LPim[p * 68 + 63 - s];
        const float m0 = ri ? li : lr, m1 = ri ? lr : -li;
        unsigned o[8];
#pragma unroll
        for (int q4 = 0; q4 < 4; ++q4) { const f32x4 yr = *(LAS f32x4*)(BBre + p * 16 + 4 * q4), yi = *(LAS f32x4*)(BBim + p * 16 + 4 * q4);
            o[2 * q4] = pk2(m0 * yr[0] + m1 * yi[0], m0 * yr[1] + m1 * yi[1]); o[2 * q4 + 1] = pk2(m0 * yr[2] + m1 * yi[2], m0 * yr[3] + m1 * yi[3]); }
        u32x4* dst = (u32x4*)(Eg + ((size_t)((pp >> 4) * 32 + (s >> 1)) * 64 + (s & 1) * 32 + (pp & 15)) * 8);
        dst[0] = (u32x4){o[0], o[1], o[2], o[3]}; dst[16] = (u32x4){o[4], o[5], o[6], o[7]};
    }
    for (int j = 0; j < 16; ++j) {
        const int id = tid + 512 * j, pq = id & 3, ri = (id >> 2) & 1, tc = id >> 3, t = tc >> 4, c = tc & 15, p0 = pq * 16;
        unsigned o[8];
#pragma unroll
        for (int q4 = 0; q4 < 4; ++q4) { const f32x4 xr = *(LAS f32x4*)(CCre + c * 64 + p0 + 4 * q4), xi = *(LAS f32x4*)(CCim + c * 64 + p0 + 4 * q4);
            const f32x4 lr = *(LAS f32x4*)(LTre + (t + 1) * 64 + p0 + 4 * q4), li = *(LAS f32x4*)(LTim + (t + 1) * 64 + p0 + 4 * q4);
            const f32x4 v = ri ? -(xr * li + xi * lr) : (xr * lr - xi * li);
            o[2 * q4] = pk2(v[0], v[1]); o[2 * q4 + 1] = pk2(v[2], v[3]); }
        const int pp0 = ri * 64 + p0;
        u32x4* dst = (u32x4*)(Fg + ((size_t)(((t & 7) * 4 + (pp0 >> 5)) * 8 + (t >> 3)) * 64 + ((pp0 & 31) >> 3) * 16 + c) * 8);
        dst[0] = (u32x4){o[0], o[1], o[2], o[3]}; dst[16] = (u32x4){o[4], o[5], o[6], o[7]};
    }
    __syncthreads();
}
__device__ __forceinline__ void rope_item(const KParams& P, int item) {
    const int e = item * 512 + threadIdx.x, pos = e >> 3, i = e & 7;
    const float inv = (float)exp_d(-(double)i * 0.125 * 13.122363377404328);
    const float ang = (float)pos * inv;
    double s, c; sincos_d((double)ang, s, c);
    float* R = (float*)(P.ws + OFF_ROPE);
    R[e * 2 + 0] = (float)c; R[e * 2 + 1] = (float)s;
}
constexpr int I_IN = (DM / 64) * (DIN / 64), I_GLU = (1024 / 64) * (1024 / 64), I_BR = (1024 / 64) * (2048 / 64), I_OUT = (2048 / 64) * (2048 / 64);
constexpr int PER_L = I_IN + I_GLU + 3 * I_BR + I_OUT;
#define TR_WINDOW(G) 0
__device__ __forceinline__ void p0_transpose_dispatch(const KParams& P, LAS unsigned char* scr, int it, int lane) {
    const int l = it / PER_L; int r = it - l * PER_L;
    if (r < I_IN) { p0_transpose_item(P.in[2] + (size_t)l * DM * DIN, DM, DIN, (bf16_t*)(P.ws + OFF_WIN + l * SZ_WIN), scr, r, lane); return; } r -= I_IN;
    if (r < I_GLU) { p0_transpose_item(P.in[11] + (size_t)l * 1024 * 1024, 1024, 1024, (bf16_t*)(P.ws + OFF_GLU + l * SZ_GLU), scr, r, lane); return; } r -= I_GLU;
    if (r < 3 * I_BR) { const int br = r / I_BR; r -= br * I_BR;
        const float* W = (br == 0 ? P.in[18] : br == 1 ? P.in[19] : P.in[20]) + (size_t)l * 1024 * 2048;
        p0_transpose_item(W, 1024, 2048, (bf16_t*)(P.ws + OFF_WBR + (size_t)(l * 3 + br) * SZ_WBR), scr, r, lane); return; } r -= 3 * I_BR;
    p0_transpose_item(P.in[21] + (size_t)l * 2048 * 2048, 2048, 2048, (bf16_t*)(P.ws + OFF_WOUT + l * SZ_WOUT), scr, r, lane);
}
__device__ __forceinline__ void p0_prologue(const KParams& P, LAS unsigned char* lds) {
    const int tid = launder((int)threadIdx.x), lane = tid & 63, wave = __builtin_amdgcn_readfirstlane(tid >> 6), G = gridDim.x;
    for (int it = blockIdx.x; it < 32; it += G) rope_item(P, it);
    __syncthreads();
    LAS unsigned char* scr = lds + wave * 16384;
    const int gw = blockIdx.x * 8 + wave, NGW = G * 8;
    for (int it = gw; it < 2 * PER_L - TR_WINDOW(G); it += NGW) p0_transpose_dispatch(P, scr, it, lane);
    for (int i = blockIdx.x * 512 + tid; i < 2 * NTOK * 2; i += G * 512) ((float*)(P.ws + OFF_ST))[i] = 0.f;
    for (int i = blockIdx.x * 512 + tid; i < NTOK; i += G * 512) ((float*)(P.ws + OFF_SSQ))[NTOK + i] = 0.f;
    for (int m = gw; m < NTOK; m += NGW) xw_row_bf16(P.in[0] + (size_t)m * DM, P.in[1], (bf16_t*)(P.ws + OFF_XN) + (size_t)m * DM, (float*)(P.ws + OFF_SSQ) + m, lane);
    __syncthreads();
}
#define MFMA16(a, b, c) __builtin_amdgcn_mfma_f32_16x16x32_bf16((a), (b), (c), 0, 0, 0)
__device__ __forceinline__ bf16x8 lds16(LAS unsigned char* p) { return *(LAS bf16x8*)p; }
__device__ __forceinline__ bf16x8 cat8(s16x4 a, s16x4 b) { return (bf16x8){a[0], a[1], a[2], a[3], b[0], b[1], b[2], b[3]}; }

template <int I0>
__device__ __forceinline__ void toep_seg(f32x4 (&acc)[8][2], LAS unsigned char* up, LAS unsigned char* kp, int w, int fq, int kk_lo, int kk_hi) {
#pragma unroll 1
    for (int kk = kk_lo; kk <= kk_hi; ++kk) {
        const bf16x8 b0 = lds16(up + kk * 64), b1 = lds16(up + 16 * 2064 + kk * 64);
        LAS unsigned char* kb = kp + (w - 2 * kk - (fq >> 1) + 1) * 512;
#pragma unroll
        for (int i4 = I0; i4 < 8; i4 += 4) {
            bf16x8 a[4];
#pragma unroll
            for (int d = 0; d < 4; ++d) if (i4 + d < 8) a[d] = lds16(kb + (i4 + d) * 8 * 512);
#pragma unroll
            for (int d = 0; d < 4; ++d) if (i4 + d < 8) { acc[i4 + d][0] = MFMA16(a[d], b0, acc[i4 + d][0]); acc[i4 + d][1] = MFMA16(a[d], b1, acc[i4 + d][1]); }
        }
    }
}
constexpr int S5_U = 0, S5_UROW = 2064, S5_KT = 66048, S5_S = 99328, S5_XP = 116224, S5_XPROW = 272;
__device__ __forceinline__ void s5_item(const KParams& P, LAS unsigned char* lds, int l, int b, int g) {
    const int tid = launder((int)threadIdx.x), lane = tid & 63, w = __builtin_amdgcn_readfirstlane(tid >> 6), fr = lane & 15, fq = lane >> 4;
    const bf16_t* proj = (const bf16_t*)(P.ws + OFF_PROJ);
    const bf16_t* KTg = (const bf16_t*)(P.ws + OFF_KT + (size_t)l * SZ_KT) + (size_t)g * 65 * 256;
    const bf16_t* Eg = (const bf16_t*)(P.ws + OFF_E + (size_t)l * SZ_E) + (size_t)g * 128 * 1024;
    const bf16_t* Fg = (const bf16_t*)(P.ws + OFF_F + (size_t)l * SZ_F) + (size_t)g * 1024 * 128;
    const float* L64 = (const float*)(P.ws + OFF_L64 + (size_t)l * SZ_L64) + (size_t)g * 128;
    bf16_t* ya0 = (bf16_t*)(P.ws + OFF_YA0);
    bf16x8 ef[32];
    {
        const bf16_t* ep = Eg + ((size_t)(w * 32) * 64 + lane) * 8;
#pragma unroll
        for (int kk = 0; kk < 32; ++kk) ef[kk] = *(const bf16x8*)(ep + kk * 512);
    }
#pragma unroll
    for (int i = 0; i < 4; ++i) { const int t = tid + 512 * i; const u32x4* src = (const u32x4*)((const bf16_t*)(P.ws + OFF_UA) + ((size_t)g * NTOK + b * SEQ + t) * 16);
        const u32x4 v0 = src[0], v1 = src[1]; LAS u32x4* dst = (LAS u32x4*)(lds + S5_U + (t >> 6) * S5_UROW + (t & 63) * 32); dst[0] = v0; dst[1] = v1; }
    for (int i = tid; i < 2080; i += 512) ((LAS u32x4*)(lds + S5_KT))[i] = ((const u32x4*)KTg)[i];
    __syncthreads();
    {
        f32x4 a0 = {0.f, 0.f, 0.f, 0.f}, a1 = {0.f, 0.f, 0.f, 0.f};
        LAS unsigned char* up = lds + S5_U + fr * S5_UROW + fq * 16;
#pragma unroll
        for (int kk = 0; kk < 32; ++kk) {
            const bf16x8 b0 = lds16(up + kk * 64), b1 = lds16(up + 16 * S5_UROW + kk * 64);
            a0 = MFMA16(ef[kk], b0, a0); a1 = MFMA16(ef[kk], b1, a1);
        }
        LAS float* S = (LAS float*)(lds + S5_S);
#pragma unroll
        for (int r = 0; r < 4; ++r) { S[(16 * w + fq * 4 + r) * 33 + fr] = a0[r]; S[(16 * w + fq * 4 + r) * 33 + 16 + fr] = a1[r]; }
    }
    bf16x8 ff[4][8];
#pragma unroll
    for (int kk = 0; kk < 4; ++kk)
#pragma unroll
        for (int i = 0; i < 8; ++i) ff[kk][i] = *(const bf16x8*)(Fg + ((size_t)((w * 4 + kk) * 8 + i) * 64 + lane) * 8);
    __syncthreads();
    if (tid < 64) {
        const int p = tid; const float lr = L64[p * 2], li = L64[p * 2 + 1];
        LAS float* S = (LAS float*)(lds + S5_S);
        float sr[32], si[32];
#pragma unroll
        for (int j = 0; j < 32; ++j) { sr[j] = S[p * 33 + j]; si[j] = S[(64 + p) * 33 + j]; }
        float xr = 0.f, xi = 0.f;
#pragma unroll
        for (int j = 0; j < 32; ++j) {
            LAS bf16_t* xp = (LAS bf16_t*)(lds + S5_XP + j * S5_XPROW);
            xp[p] = (bf16_t)f2bf(xr); xp[64 + p] = (bf16_t)f2bf(xi);
            const float nr = lr * xr - li * xi + sr[j], ni = lr * xi + li * xr + si[j]; xr = nr; xi = ni;
        }
    }
    __syncthreads();
    {
        f32x4 acc[8][2];
#pragma unroll
        for (int i = 0; i < 8; ++i) { acc[i][0] = (f32x4){0.f, 0.f, 0.f, 0.f}; acc[i][1] = (f32x4){0.f, 0.f, 0.f, 0.f}; }
        LAS unsigned char* up = lds + S5_U + fr * S5_UROW + fq * 16;
        LAS unsigned char* kp = lds + S5_KT + fr * 32 + (fq & 1) * 16;
        toep_seg<0>(acc, up, kp, w, fq, 0, w >> 1);
        toep_seg<1>(acc, up, kp, w, fq, (w >> 1) + 1, (w + 8) >> 1);
        toep_seg<2>(acc, up, kp, w, fq, ((w + 8) >> 1) + 1, (w + 16) >> 1);
        toep_seg<3>(acc, up, kp, w, fq, ((w + 16) >> 1) + 1, (w + 24) >> 1);
        toep_seg<4>(acc, up, kp, w, fq, ((w + 24) >> 1) + 1, (w + 32) >> 1);
        toep_seg<5>(acc, up, kp, w, fq, ((w + 32) >> 1) + 1, (w + 40) >> 1);
        toep_seg<6>(acc, up, kp, w, fq, ((w + 40) >> 1) + 1, (w + 48) >> 1);
        toep_seg<7>(acc, up, kp, w, fq, ((w + 48) >> 1) + 1, (w + 56) >> 1);
        LAS unsigned char* xp = lds + S5_XP + fr * S5_XPROW + fq * 16;
#pragma unroll
        for (int kk = 0; kk < 4; ++kk) {
            const bf16x8 b0 = lds16(xp + kk * 64), b1 = lds16(xp + 16 * S5_XPROW + kk * 64);
#pragma unroll
            for (int i = 0; i < 8; ++i) { acc[i][0] = MFMA16(ff[kk][i], b0, acc[i][0]); acc[i][1] = MFMA16(ff[kk][i], b1, acc[i][1]); }
        }
        const f32x4 dv = *(const f32x4*)(P.in[10] + (size_t)l * 1024 + g * 16 + fq * 4);
#pragma unroll
        for (int i = 0; i < 8; ++i)
#pragma unroll
            for (int nt = 0; nt < 2; ++nt) { const int t = w + 8 * i, j = nt * 16 + fr;
                const u32x2 uu = *(LAS u32x2*)(lds + S5_U + j * S5_UROW + t * 32 + fq * 8);
                const float y0 = gelu_f(acc[i][nt][0] + dv[0] * bflo(uu.x)), y1 = gelu_f(acc[i][nt][1] + dv[1] * bfhi(uu.x));
                const float y2 = gelu_f(acc[i][nt][2] + dv[2] * bflo(uu.y)), y3 = gelu_f(acc[i][nt][3] + dv[3] * bfhi(uu.y));
                u32x2 o; o.x = cvt_pk_bf16(y0, y1); o.y = cvt_pk_bf16(y2, y3);
                *(u32x2*)(ya0 + (size_t)(b * SEQ + j * 64 + t) * 1024 + g * 16 + fq * 4) = o; }
    }
    __syncthreads();
}

constexpr int SG_ST = 0, SG_R = 1024, SG_W = 2048, SG_ROW = 272;
__device__ __forceinline__ void sg_item(const KParams& P, LAS unsigned char* lds, int l, int chunk, int h) {
    const int tid = launder((int)threadIdx.x), lane = tid & 63, w = __builtin_amdgcn_readfirstlane(tid >> 6), fr = lane & 15, fq = lane >> 4;
    const bf16_t* proj = (const bf16_t*)(P.ws + OFF_PROJ);
    const int tok0 = chunk * 128;
    LAS float* ST = (LAS float*)(lds + SG_ST); LAS float* R = (LAS float*)(lds + SG_R);
    const bf16_t* vbt = (const bf16_t*)(P.ws + OFF_VBT) + ((size_t)chunk * 1024 + h * 128 + 16 * w + fr) * 128 + fq * 8;
    bf16x8 af[4];
#pragma unroll
    for (int kk = 0; kk < 4; ++kk) af[kk] = *(const bf16x8*)(vbt + kk * 32);
    const float* Wg = P.in[15] + (size_t)(l * 8 + h) * 16384;
    f32x4 wx[8];
#pragma unroll
    for (int i = 0; i < 8; ++i) { const int idx = tid + 512 * i; wx[i] = *(const f32x4*)(Wg + (idx >> 5) * 128 + (idx & 31) * 4); }
    if (tid < 128) { const float* st = (const float*)(P.ws + OFF_ST) + (size_t)l * NTOK * 2 + (size_t)(tok0 + tid) * 2;
        const float mean = st[0] * (1.0f / 1024.0f), var = fmaxf(st[1] * (1.0f / 1024.0f) - mean * mean, 0.f);
        ST[tid * 2] = mean; ST[tid * 2 + 1] = 1.0f / sqrtf(var + EPS); }
    __syncthreads();
#pragma unroll
    for (int i = 0; i < 8; ++i) { const int idx = tid + 512 * i, t = idx >> 5, s4 = (idx & 31) * 4; const f32x4 x = wx[i];
        const f32x4 m0 = *(LAS f32x4*)(ST + s4 * 2), m1 = *(LAS f32x4*)(ST + s4 * 2 + 4);
        const float x0 = s4 <= t ? x[0] : 0.f, x1 = s4 + 1 <= t ? x[1] : 0.f, x2 = s4 + 2 <= t ? x[2] : 0.f, x3 = s4 + 3 <= t ? x[3] : 0.f;
        u32x2 o; o.x = pk2(x0 * m0[1], x1 * m0[3]); o.y = pk2(x2 * m1[1], x3 * m1[3]);
        float r1 = bflo(o.x) * m0[0] + bfhi(o.x) * m0[2] + bflo(o.y) * m1[0] + bfhi(o.y) * m1[2], r2 = (x0 + x1) + (x2 + x3);
        *(LAS u32x2*)(lds + SG_W + t * SG_ROW + s4 * 2) = o;
#pragma unroll
        for (int d = 1; d < 32; d <<= 1) { r1 += __shfl_xor(r1, d); r2 += __shfl_xor(r2, d); }
        if ((idx & 31) == 0) { R[t * 2] = r1; R[t * 2 + 1] = r2; } }
    const int cc = h * 128 + 16 * w + fq * 4;
    u32x2 gu8[8], sz8[8];
#pragma unroll
    for (int nt = 0; nt < 8; ++nt) { const bf16_t* prow = proj + (size_t)(tok0 + nt * 16 + fr) * DIN; gu8[nt] = *(const u32x2*)(prow + C_UB + cc); sz8[nt] = *(const u32x2*)(prow + C_ZB + cc); }
    __syncthreads();
    f32x4 acc[8];
#pragma unroll
    for (int nt = 0; nt < 8; ++nt) acc[nt] = (f32x4){0.f, 0.f, 0.f, 0.f};
#pragma unroll
    for (int kk = 0; kk < 4; ++kk) {
#pragma unroll
        for (int nt = 0; nt < 8; ++nt) { const bf16x8 bq = lds16(lds + SG_W + (nt * 16 + fr) * SG_ROW + kk * 64 + fq * 16); acc[nt] = MFMA16(af[kk], bq, acc[nt]); } }
    const float* sgb = P.in[16] + (size_t)(l * 8 + h) * 128;
    const f32x4 lw = *(const f32x4*)(P.in[13] + (size_t)l * 1024 + cc), lb = *(const f32x4*)(P.in[14] + (size_t)l * 1024 + cc);
    bf16_t* yb = (bf16_t*)(P.ws + OFF_YB);
#pragma unroll
    for (int nt = 0; nt < 8; ++nt) { const int t = nt * 16 + fr; const float bias = sgb[t]; const float r1 = R[t * 2], r2 = R[t * 2 + 1];
        const u32x2 gu = gu8[nt], sz = sz8[nt];
        const float o0 = bflo(gu.x) * (lw[0] * (acc[nt][0] - r1) + lb[0] * r2 + bias) * bflo(sz.x), o1 = bfhi(gu.x) * (lw[1] * (acc[nt][1] - r1) + lb[1] * r2 + bias) * bfhi(sz.x);
        const float o2 = bflo(gu.y) * (lw[2] * (acc[nt][2] - r1) + lb[2] * r2 + bias) * bflo(sz.y), o3 = bfhi(gu.y) * (lw[3] * (acc[nt][3] - r1) + lb[3] * r2 + bias) * bfhi(sz.y);
        u32x2 o; o.x = cvt_pk_bf16(o0, o1); o.y = cvt_pk_bf16(o2, o3);
        *(u32x2*)(yb + (size_t)(tok0 + t) * 1024 + cc) = o; }
    __syncthreads();
}

constexpr int AT_KS = 0, AT_KROW = 144, AT_VT = 36864, AT_VROW = 528;
__device__ __forceinline__ void attn_item(const KParams& P, LAS unsigned char* lds, int l, int blk, int kvh, int half) {
    const int tid = launder((int)threadIdx.x), lane = tid & 63, w = __builtin_amdgcn_readfirstlane(tid >> 6), fr = lane & 15, fq = lane >> 4;
    const bf16_t* proj = (const bf16_t*)(P.ws + OFF_PROJ);
    const int n = blk & 15, b = blk >> 4, tok0 = blk * 128;
    const int tile0 = w < 6 ? w : 6;
    const int q = 16 * w + fr;
    const bf16_t* qbase = proj + (size_t)(tok0 + q) * DIN + C_Q + (kvh * 8 + half * 4) * 64 + fq * 8;
    bf16x8 qn0 = *(const bf16x8*)qbase, qn1 = *(const bf16x8*)(qbase + 32);
    {
        u32x4 kv[4], vv[4];
        const u32x4 z4 = {0u, 0u, 0u, 0u};
        const bf16_t* vtt = (const bf16_t*)(P.ws + OFF_VTT) + (size_t)(b * 2 + kvh) * 64 * 2048 + n * 128 - 128;
#pragma unroll
        for (int i = 0; i < 4; ++i) { const int idx = tid + 512 * i, row = idx >> 3, ch = idx & 7;
            kv[i] = ((n > 0) || (row >= 128)) ? *(const u32x4*)(proj + (size_t)(tok0 - 128 + row) * DIN + C_K + kvh * 64 + ch * 8) : z4; }
#pragma unroll
        for (int i = 0; i < 4; ++i) { const int idx = tid + 512 * i, d = idx >> 5, ch = idx & 31;
            vv[i] = ((n > 0) || (ch >= 16)) ? *(const u32x4*)(vtt + (size_t)d * 2048 + ch * 8) : z4; }
#pragma unroll
        for (int i = 0; i < 4; ++i) { const int idx = tid + 512 * i; *(LAS u32x4*)(lds + AT_KS + (idx >> 3) * AT_KROW + (idx & 7) * 16) = kv[i];
            *(LAS u32x4*)(lds + AT_VT + (idx >> 5) * AT_VROW + (idx & 31) * 16) = vv[i]; }
    }
    __syncthreads();
#pragma unroll 1
    for (int hh = 0; hh < 4; ++hh) {
        const int hq = kvh * 8 + half * 4 + hh;
        const bf16x8 qb0 = qn0, qb1 = qn1;
        if (hh < 3) { qn0 = *(const bf16x8*)(qbase + (hh + 1) * 64); qn1 = *(const bf16x8*)(qbase + (hh + 1) * 64 + 32); }
        const u32x2 zc0 = *(const u32x2*)(proj + (size_t)(tok0 + q) * DIN + C_ZC + hq * 64 + fq * 4);
        f32x4 s[10];
#pragma unroll
        for (int kt = 0; kt < 10; ++kt) { LAS unsigned char* kp = lds + AT_KS + ((tile0 + kt) * 16 + fr) * AT_KROW + fq * 16;
            f32x4 a = {0.f, 0.f, 0.f, 0.f}; a = MFMA16(lds16(kp), qb0, a); a = MFMA16(lds16(kp + 64), qb1, a); s[kt] = a; }
        const float sink = P.in[17][l * 16 + hq];
        float mx = sink;
#pragma unroll
        for (int kt = 0; kt < 10; ++kt)
#pragma unroll
            for (int r = 0; r < 4; ++r) { const int idx = (tile0 + kt) * 16 + fq * 4 + r; const bool ok = (idx >= q + 1) && (idx <= q + 128) && ((n > 0) || (idx >= 128));
                s[kt][r] = ok ? s[kt][r] : -1e30f; mx = fmaxf(mx, s[kt][r]); }
        mx = fmaxf(mx, __shfl_xor(mx, 16)); mx = fmaxf(mx, __shfl_xor(mx, 32));
        float sum = 0.f;
#pragma unroll
        for (int kt = 0; kt < 10; ++kt)
#pragma unroll
            for (int r = 0; r < 4; ++r) { s[kt][r] = __expf(s[kt][r] - mx); sum += s[kt][r]; }
        sum += __shfl_xor(sum, 16); sum += __shfl_xor(sum, 32);
        const float inv = 1.0f / (sum + __expf(sink - mx));
        bf16x8 pb[5];
#pragma unroll
        for (int pp = 0; pp < 5; ++pp) { u32x4 t4; t4.x = cvt_pk_bf16(s[2 * pp][0] * inv, s[2 * pp][1] * inv); t4.y = cvt_pk_bf16(s[2 * pp][2] * inv, s[2 * pp][3] * inv);
            t4.z = cvt_pk_bf16(s[2 * pp + 1][0] * inv, s[2 * pp + 1][1] * inv); t4.w = cvt_pk_bf16(s[2 * pp + 1][2] * inv, s[2 * pp + 1][3] * inv); pb[pp] = __builtin_bit_cast(bf16x8, t4); }
        bf16_t* yc = (bf16_t*)(P.ws + OFF_YC);
        const bf16_t* zrow = proj + (size_t)(tok0 + q) * DIN + C_ZC + hq * 64;
#pragma unroll
        for (int dt = 0; dt < 4; ++dt) { f32x4 o = {0.f, 0.f, 0.f, 0.f};
#pragma unroll
            for (int pp = 0; pp < 5; ++pp) { LAS unsigned char* vp = lds + AT_VT + (dt * 16 + fr) * AT_VROW + ((tile0 + 2 * pp) * 16 + fq * 4) * 2;
                o = MFMA16(cat8(*(LAS s16x4*)vp, *(LAS s16x4*)(vp + 32)), pb[pp], o); }
            const u32x2 zc = dt == 0 ? zc0 : *(const u32x2*)(zrow + dt * 16 + fq * 4);
            u32x2 ov; ov.x = cvt_pk_bf16(o[0] * bflo(zc.x), o[1] * bfhi(zc.x)); ov.y = cvt_pk_bf16(o[2] * bflo(zc.y), o[3] * bfhi(zc.y));
            *(u32x2*)(yc + (size_t)(tok0 + q) * 1024 + hq * 64 + dt * 16 + fq * 4) = ov; }
    }
    __syncthreads();
}
__global__ void __launch_bounds__(512, 2) hybrid_fwd(KParams P) {
    extern __shared__ __attribute__((aligned(16))) unsigned char lds_raw[];
    LAS unsigned char* lds = (LAS unsigned char*)lds_raw;
    cg::grid_group grid = cg::this_grid();
    unsigned char* ws = P.ws;
    const int G = gridDim.x;
    bf16_t* XN = (bf16_t*)(ws + OFF_XN); float* XB = (float*)(ws + OFF_X); bf16_t* PROJ = (bf16_t*)(ws + OFF_PROJ);
    bf16_t* YA0 = (bf16_t*)(ws + OFF_YA0); bf16_t* YA = (bf16_t*)(ws + OFF_YA); bf16_t* YB = (bf16_t*)(ws + OFF_YB); bf16_t* YC = (bf16_t*)(ws + OFF_YC);
    bf16_t* MG = (bf16_t*)(ws + OFF_MG);

    if (threadIdx.x < 16) ((LAS unsigned*)(lds + 131072))[threadIdx.x] = 0u;
    __syncthreads();
    if (blockIdx.x == 0) for (int i = threadIdx.x; i < 4096; i += 512) ((unsigned*)(ws + OFF_BAR))[i] = 0u;
    p0_prologue(P, lds);
    grid.sync();
    const XcdBarrier xb = xcd_barrier_post((unsigned*)(ws + OFF_BAR), (volatile LAS unsigned*)(lds + 131072));
#pragma unroll 1
    for (int l = 0; l < 2; ++l) {
        {
            const bf16_t* W = (const bf16_t*)(ws + OFF_WIN + (size_t)l * SZ_WIN);
            pg8::Gemm g{XN, XN, XN, W, W, W, NTOK, DIN, DM}; pg8::Order S; S.init(NTOK, DIN, G, (int)blockIdx.x, 1); S.rot = 7;
            EpiProj E{PROJ, (bf16_t*)(ws + OFF_VBT), (bf16_t*)(ws + OFF_VTT), (float*)(ws + OFF_ST) + (size_t)l * NTOK * 2, (const float*)(ws + OFF_ROPE), 0, (const float*)(ws + OFF_SSQ) + (size_t)l * NTOK, (bf16_t*)(ws + OFF_UA)};
            for (int it = G - 1 - (int)blockIdx.x; it < 64; it += G) s5_tables_item(P, lds, l, it);
            pg8::gemm_phase<EpiProj>(lds, g, S, E);
        }
        xcd_barrier(xb);
        for (unsigned i = blockIdx.x * 512u + threadIdx.x; i < (unsigned)(SZ_GLU / 128); i += (unsigned)G * 512u) (void)*(volatile const unsigned*)(ws + OFF_GLU + (size_t)l * SZ_GLU + (size_t)i * 128);
#pragma unroll 1
        for (int it = blockIdx.x; it < 768; it += G) {
            if (it < 256) s5_item(P, lds, l, it >> 6, it & 63);
            else { const int i2 = it - 256; sg_item(P, lds, l, i2 >> 3, i2 & 7); }
        }
        xcd_barrier(xb);
        if (G > 128 && blockIdx.x >= 128) {
            const unsigned nth = (unsigned)(G - 128) * 512u, t0 = ((unsigned)blockIdx.x - 128u) * 512u + threadIdx.x;
            const unsigned char* wb = ws + OFF_WBR + (size_t)l * 3 * SZ_WBR; const unsigned char* wo = ws + OFF_WOUT + (size_t)l * SZ_WOUT;
            for (unsigned i = t0; i < (unsigned)(3 * SZ_WBR / 128); i += nth) (void)*(volatile const unsigned*)(wb + (size_t)i * 128);
            for (unsigned i = t0; i < (unsigned)(SZ_WOUT / 128); i += nth) (void)*(volatile const unsigned*)(wo + (size_t)i * 128);
        }
#pragma unroll 1
        for (int it = (G > 128) ? (((int)blockIdx.x >= 128) ? G - 1 - (int)blockIdx.x : 256) : (int)blockIdx.x; it < 256; it += (G > 128 ? G - 128 : G)) attn_item(P, lds, l, it >> 2, (it >> 1) & 1, it & 1);
        {
            const bf16_t* W = (const bf16_t*)(ws + OFF_GLU + (size_t)l * SZ_GLU);
            const int glu_lo = 0, gc = (int)blockIdx.x - glu_lo;
            pg8::Gemm g{YA0, YA0, YA0, W, W, W, NTOK, 1024, 1024}; pg8::Order S; S.init(NTOK, 1024, G - glu_lo, gc >= 0 ? gc : (1 << 20), 1);
            EpiGlu E{P.in[12] + (size_t)l * 1024, YA0, PROJ, YA};
            pg8::gemm_phase<EpiGlu>(lds, g, S, E);
        }
        xcd_barrier(xb);
        {
            const bf16_t* W0 = (const bf16_t*)(ws + OFF_WBR + (size_t)(l * 3 + 0) * SZ_WBR);
            const bf16_t* W1 = (const bf16_t*)(ws + OFF_WBR + (size_t)(l * 3 + 1) * SZ_WBR);
            const bf16_t* W2 = (const bf16_t*)(ws + OFF_WBR + (size_t)(l * 3 + 2) * SZ_WBR);
            pg8::Gemm g{YA, YB, YC, W0, W1, W2, NTOK, DM, 1024}; pg8::Order S; S.init(NTOK, DM, G, (int)blockIdx.x, 3);
            EpiMerge E{PROJ, MG};
            pg8::gemm_phase<EpiMerge>(lds, g, S, E);
        }
        xcd_barrier(xb);
        {
            const bf16_t* W = (const bf16_t*)(ws + OFF_WOUT + (size_t)l * SZ_WOUT);
            pg8::Gemm g{MG, MG, MG, W, W, W, NTOK, DM, DM}; pg8::Order S; S.init(NTOK, DM, G, (int)blockIdx.x, 1);
            EpiOut E{l == 0 ? P.in[0] : (const float*)XB, XB, l == 0 ? XN : (bf16_t*)nullptr, P.in[1] + DM, (float*)(ws + OFF_SSQ) + NTOK};
            pg8::gemm_phase<EpiOut>(lds, g, S, E);
        }
        xcd_barrier(xb);
        const int tid = launder((int)threadIdx.x), lane = tid & 63, wave = __builtin_amdgcn_readfirstlane(tid >> 6);
        const int gw = blockIdx.x * 8 + wave, NGW = G * 8;
        if (l == 0) {
        } else {
            for (int m = gw; m < NTOK; m += NGW) rms_row_f32(XB + (size_t)m * DM, P.in[22], P.out + (size_t)m * DM, lane);
        }
    }
}

extern "C" void kernel_launch(void* const* d_in, const int* in_sizes, int n_in, void* d_out, int out_size, void* d_ws, size_t ws_size, hipStream_t stream) {
    static int grid_blocks = 0;
    if (grid_blocks == 0) {
        if (n_in != 23 || ws_size < WS_END) { fprintf(stderr, "kernel_launch: unexpected n_in %d / ws_size %zu (need %zu)\n", n_in, ws_size, (size_t)WS_END); grid_blocks = -1; return; }
        int dev = 0, cus = 0, per_cu = 0;
        hipGetDevice(&dev);
        hipDeviceGetAttribute(&cus, hipDeviceAttributeMultiprocessorCount, dev);
        hipFuncSetAttribute((const void*)hybrid_fwd, hipFuncAttributeMaxDynamicSharedMemorySize, LDS_BYTES);
        hipOccupancyMaxActiveBlocksPerMultiprocessor(&per_cu, (const void*)hybrid_fwd, 512, LDS_BYTES);
        if (per_cu < 1) { fprintf(stderr, "kernel_launch: occupancy query reports %d blocks per CU\n", per_cu); per_cu = 1; }
        if (per_cu > 1) per_cu = 1;
        grid_blocks = cus * per_cu;
        (void)hipGetLastError();
    }
    if (grid_blocks < 0) return;
    KParams p{};
    for (int i = 0; i < 23; ++i) p.in[i] = (const float*)d_in[i];
    p.out = (float*)d_out; p.ws = (unsigned char*)d_ws;
    void* args[] = {&p};
    hipError_t e = hipLaunchCooperativeKernel((const void*)hybrid_fwd, dim3(grid_blocks), dim3(512), args, LDS_BYTES, stream);
    if (e != hipSuccess) fprintf(stderr, "cooperative launch failed: %s (grid %d)\n", hipGetErrorString(e), grid_blocks);
}
```

```cpp
#include <hip/hip_runtime.h>
#include <hip/hip_cooperative_groups.h>
#include <cstdio>
#include <cstdint>
namespace cg = cooperative_groups;

#define LAS __attribute__((address_space(3)))
typedef unsigned short bf16_t;
typedef short bf16x8 __attribute__((ext_vector_type(8)));
typedef short s16x4 __attribute__((ext_vector_type(4)));
typedef float f32x4 __attribute__((ext_vector_type(4)));
typedef float f32x2 __attribute__((ext_vector_type(2)));
typedef unsigned u32x4 __attribute__((ext_vector_type(4)));
typedef unsigned u32x2 __attribute__((ext_vector_type(2)));

constexpr int NTOK = 8192, DM = 2048, DIN = 13568, SEQ = 2048;
constexpr int C_UA = 0, C_ZA = 1024, C_UB = 2048, C_VB = 3072, C_ZB = 4096, C_Q = 5120, C_K = 6144, C_V = 6272, C_ZC = 6400, C_G = 7424;
constexpr float EPS = 1e-6f;

constexpr size_t SZ_WIN = (size_t)DIN * DM * 2, SZ_GLU = (size_t)1024 * 1024 * 2, SZ_WBR = (size_t)2048 * 1024 * 2, SZ_WOUT = (size_t)2048 * 2048 * 2;
constexpr size_t SZ_KT = (size_t)64 * 65 * 512, SZ_E = (size_t)64 * 128 * 1024 * 2, SZ_F = SZ_E, SZ_L64 = (size_t)64 * 64 * 8;
constexpr size_t OFF_WIN = 0;
constexpr size_t OFF_GLU = OFF_WIN + 2 * SZ_WIN;
constexpr size_t OFF_WBR = OFF_GLU + 2 * SZ_GLU;
constexpr size_t OFF_WOUT = OFF_WBR + 6 * SZ_WBR;
constexpr size_t OFF_KT = OFF_WOUT + 2 * SZ_WOUT;
constexpr size_t OFF_E = OFF_KT + 2 * SZ_KT;
constexpr size_t OFF_F = OFF_E + 2 * SZ_E;
constexpr size_t OFF_L64 = OFF_F + 2 * SZ_F;
constexpr size_t OFF_ROPE = OFF_L64 + 2 * SZ_L64;
constexpr size_t OFF_XN = OFF_ROPE + (size_t)2048 * 16 * 4;
constexpr size_t OFF_X = OFF_XN + (size_t)NTOK * DM * 2;
constexpr size_t OFF_PROJ = OFF_X + (size_t)NTOK * DM * 4;
constexpr size_t OFF_YA0 = OFF_PROJ + (size_t)NTOK * DIN * 2;
constexpr size_t OFF_YA = OFF_YA0 + (size_t)NTOK * 1024 * 2;
constexpr size_t OFF_YB = OFF_YA + (size_t)NTOK * 1024 * 2;
constexpr size_t OFF_YC = OFF_YB + (size_t)NTOK * 1024 * 2;
constexpr size_t OFF_MG = OFF_YC + (size_t)NTOK * 1024 * 2;
constexpr size_t OFF_VBT = OFF_MG + (size_t)NTOK * DM * 2;
constexpr size_t OFF_VTT = OFF_VBT + (size_t)NTOK * 1024 * 2;
constexpr size_t OFF_ST = OFF_VTT + (size_t)8 * 64 * 2048 * 2;
constexpr size_t OFF_BAR = OFF_ST + (size_t)2 * NTOK * 2 * 4;
constexpr size_t OFF_SSQ = OFF_BAR + 16384;
constexpr size_t OFF_UA = OFF_SSQ + (size_t)2 * NTOK * 4;
constexpr size_t WS_END = OFF_UA + (size_t)NTOK * 1024 * 2;
static_assert(OFF_KT % 256 == 0 && OFF_E % 256 == 0 && OFF_XN % 256 == 0 && OFF_PROJ % 256 == 0 && OFF_YA0 % 256 == 0, "alignment");

constexpr int LDS_BYTES = 131072 + 64 + 1024;

__device__ __forceinline__ int launder(int x) { asm volatile("" : "+v"(x)); return x; }
__device__ __forceinline__ unsigned f2bf(float f) { unsigned u = __builtin_bit_cast(unsigned, f); return (u + 0x7fffu + ((u >> 16) & 1u)) >> 16; }
__device__ __forceinline__ unsigned pk2(float lo, float hi) { return f2bf(lo) | (f2bf(hi) << 16); }
__device__ __forceinline__ unsigned cvt_pk_bf16(float lo, float hi) { unsigned r; asm volatile("v_cvt_pk_bf16_f32 %0, %1, %2" : "=v"(r) : "v"(lo), "v"(hi)); return r; }
__device__ __forceinline__ float bflo(unsigned u) { return __builtin_bit_cast(float, u << 16); }
__device__ __forceinline__ float bfhi(unsigned u) { return __builtin_bit_cast(float, u & 0xffff0000u); }
__device__ __forceinline__ float bf1(bf16_t h) { return __builtin_bit_cast(float, (unsigned)h << 16); }
__device__ __forceinline__ float sigm(float x) { return __builtin_amdgcn_rcpf(1.0f + __expf(-x)); }
__device__ __forceinline__ float silu_f(float x) { return x * sigm(x); }
__device__ __forceinline__ float gelu_f(float x) { return x * sigm(1.5957691216057308f * (x + 0.044715f * x * x * x)); }
__device__ __forceinline__ float wave_sum(float v) {
#pragma unroll
    for (int o = 1; o < 64; o <<= 1) v += __shfl_xor(v, o);
    return v;
}
__device__ __forceinline__ void unpack8(u32x4 w, float* f) { f[0] = bflo(w.x); f[1] = bfhi(w.x); f[2] = bflo(w.y); f[3] = bfhi(w.y); f[4] = bflo(w.z); f[5] = bfhi(w.z); f[6] = bflo(w.w); f[7] = bfhi(w.w); }
__device__ __forceinline__ void sincos_d(double x, double& s, double& c) {
    const double TWO_PI = 6.283185307179586476925;
    const double n = rint(x / TWO_PI);
    const double r = fma(-n, TWO_PI, x), r2 = r * r;
    double ts = r, tc = 1.0; s = r; c = 1.0;
    _Pragma("unroll") for (int k = 1; k <= 18; ++k) { tc *= -r2 * (1.0 / (double)((2 * k - 1) * (2 * k))); c += tc; ts *= -r2 * (1.0 / (double)((2 * k) * (2 * k + 1))); s += ts; }
}
__device__ __forceinline__ double exp_d(double x) {
    const double LN2 = 0.693147180559945309417;
    const double n = rint(x / LN2);
    const double r = fma(-n, LN2, x);
    double t = 1.0, s = 1.0;
    _Pragma("unroll") for (int k = 1; k <= 16; ++k) { t *= r * (1.0 / (double)k); s += t; }
    return ldexp(s, (int)n);
}
#define XB_TMO      128
#define XB_XCNT(j)  (256  + 64 * (j))
#define XB_XSUB(j)  (1280 + 64 * (j))
#define XB_XGEN(j)  (2304 + 64 * (j))
#define XB_TOP      3328
#define XB_TOPGEN   3392
#define XCD_BAR_WORDS 3456
#define XB_SPIN_CAP (1u << 18)

__device__ __forceinline__ unsigned xb_ld(unsigned* p)              { return __hip_atomic_load(p, __ATOMIC_RELAXED, __HIP_MEMORY_SCOPE_AGENT); }
__device__ __forceinline__ unsigned xb_add(unsigned* p, unsigned v) { return __hip_atomic_fetch_add(p, v, __ATOMIC_RELAXED, __HIP_MEMORY_SCOPE_AGENT); }
__device__ __forceinline__ unsigned xb_xcc_id() { return (unsigned)__builtin_amdgcn_s_getreg((3 << 11) | 20) & 0xFu; }
#define XB_SPIN(cond, bar) do { unsigned _sp = 0; while (cond) { __builtin_amdgcn_s_sleep(1); \
    if ((++_sp & 255u) == 0u) { if (xb_ld(&(bar)[XB_TMO])) break; if (_sp > XB_SPIN_CAP) { atomicAdd(&(bar)[XB_TMO], 1u); break; } } } } while (0)

struct XcdBarrier {
    unsigned* bar; unsigned x;
    volatile LAS unsigned* st;
};

__device__ __forceinline__ XcdBarrier xcd_barrier_post(unsigned* bar, volatile LAS unsigned* st) {
    XcdBarrier b; b.bar = bar; b.x = xb_xcc_id(); b.st = st;
    if (threadIdx.x == 0) (void)xb_add(&bar[XB_XCNT(b.x)], 1u);
    return b;
}
__device__ __forceinline__ void xcd_barrier_complete(unsigned* bar, unsigned x, unsigned& nloc, unsigned& nx) {
    const unsigned G = gridDim.x * gridDim.y * gridDim.z;
    unsigned sum, cnt, mine, sp = 0u;
    for (;;) {
        sum = 0u; cnt = 0u; mine = 0u;
#pragma unroll
        for (unsigned j = 0; j < 16; ++j) { const unsigned c = xb_ld(&bar[XB_XCNT(j)]); sum += c; cnt += (c > 0u) ? 1u : 0u; mine = (j == x) ? c : mine; }
        if (sum == G) break;
        __builtin_amdgcn_s_sleep(1);
        if ((++sp & 255u) == 0u) { if (xb_ld(&bar[XB_TMO])) break; if (sp > XB_SPIN_CAP) { atomicAdd(&bar[XB_TMO], 1u); break; } }
    }
    nloc = mine > 0u ? mine : 1u; nx = cnt > 0u ? cnt : 1u;
}

__device__ __forceinline__ void xcd_barrier(const XcdBarrier& b) {
    asm volatile("s_waitcnt vmcnt(0)" ::: "memory");
    __syncthreads();
    if (threadIdx.x == 0) {
        unsigned* bar = b.bar;
        __builtin_amdgcn_s_waitcnt(0);
        unsigned nloc = b.st[0], nx = b.st[1];
        if (nloc == 0u) { xcd_barrier_complete(bar, b.x, nloc, nx); b.st[0] = nloc; b.st[1] = nx; }
        const unsigned old = xb_add(&bar[XB_XSUB(b.x)], 1u);
        const unsigned gen = old / nloc;
        if (old + 1u == (gen + 1u) * nloc) {
            __builtin_amdgcn_fence(__ATOMIC_RELEASE, "agent");
            asm volatile("s_waitcnt vmcnt(0)" ::: "memory");
            const unsigned og = xb_add(&bar[XB_TOP], 1u);
            const unsigned tg = og / nx;
            if (og + 1u == (tg + 1u) * nx) xb_add(&bar[XB_TOPGEN], 1u);
            else XB_SPIN(xb_ld(&bar[XB_TOPGEN]) == tg, bar);
            __builtin_amdgcn_fence(__ATOMIC_ACQUIRE, "agent");
            xb_add(&bar[XB_XGEN(b.x)], 1u);
            asm volatile("s_waitcnt vmcnt(0)" ::: "memory");
        } else {
            XB_SPIN(xb_ld(&bar[XB_XGEN(b.x)]) == gen, bar);
            __builtin_amdgcn_fence(__ATOMIC_ACQUIRE, "agent");
            asm volatile("s_waitcnt vmcnt(0)" ::: "memory");
        }
    }
    __syncthreads();
}

namespace pg8 {
#define PG8_LAS __attribute__((address_space(3)))
constexpr int BM = 256, BK = 64, HALF = 128, HTB = HALF * BK * 2, STAGE_BYTES = 8 * HTB, NXCD = 8, WGM = 4;
__device__ __forceinline__ int lds_byte(int r, int c) { const int st = (r >> 4) * 2 + (c >> 5), rr = r & 15, cc = c & 31, ob = rr * 64 + cc * 2; return st * 1024 + (ob ^ (((ob >> 9) & 1) << 5)); }
__device__ __forceinline__ void stage_rc(int b, int& R, int& C) { const int st = b / 1024, sb = b % 1024, swz = sb ^ (((sb >> 9) & 1) << 5); R = (st >> 1) * 16 + swz / 64; C = (st & 1) * 32 + (swz % 64) / 2; }
__device__ __forceinline__ int perm32(int rho) { const int n = rho >> 4, i = rho & 15; return 8 * (i >> 2) + 4 * n + (i & 3); }

struct Unit { int pm, pn, seg; };
struct Gemm { const bf16_t* A0; const bf16_t* A1; const bf16_t* A2; const bf16_t* B0; const bf16_t* B1; const bf16_t* B2; int M, N, K; };
struct Order {
    int nM, nN, nwg, G, c, nseg, rot;
    __device__ __forceinline__ void init(int M, int N, int G_, int c_, int nseg_) { nM = M / BM; nN = N / BM; nwg = nM * nN; G = G_; c = c_; nseg = nseg_; rot = 0; }
    __device__ __forceinline__ bool next(int i, Unit& u) const {
        const int ti = (nseg == 1) ? i : i / 3; u.seg = (nseg == 1) ? 0 : i - 3 * ti;
        const long L = (long)ti * G + c; if (L >= nwg) return false;
        int wgid = (int)L; { const int q = nwg / NXCD, r = nwg % NXCD, xcd = wgid % NXCD, off = wgid / NXCD; wgid = (xcd < r ? xcd * (q + 1) : r * (q + 1) + (xcd - r) * q) + off; }
        const int nig = WGM * nN, gid = wgid / nig, fm = gid * WGM, gsz = (nM - fm) < WGM ? (nM - fm) : WGM;
        u.pm = fm + ((wgid % nig) % gsz); int pn = (wgid % nig) / gsz;
        if (rot != 0 && (nwg % NXCD) == 0 && ((nwg / NXCD) % nig) == 0 && (nM % WGM) == 0) pn = (pn + rot * (wgid / (nwg / NXCD))) % nN;
        u.pn = pn; return true;
    }
};
template <class Epi>
__device__ __forceinline__ void gemm_phase(PG8_LAS unsigned char* lds, const Gemm g, const Order& S, const Epi& E) {
    const int tid = launder((int)threadIdx.x), wid = __builtin_amdgcn_readfirstlane(tid >> 6), lane = tid & 63, wr = wid >> 2, wc = wid & 3, fr = lane & 15, fq = lane >> 4;
    const int K = g.K, nt = K / BK;
    unsigned voffA[2], voffB[2];
#pragma unroll
    for (int i = 0; i < 2; ++i) { int R, C; stage_rc(tid * 16 + i * 8192, R, C); const int Rb = (R & ~31) + perm32(R & 31);
        voffA[i] = (unsigned)(R * K + C) * 2u; voffB[i] = (unsigned)(Rb * K + C) * 2u; }
    const size_t kstep = (size_t)(BK * 2);
    const size_t hstep = (size_t)HALF * K * 2;
    const size_t tstep = 2 * hstep;
    const unsigned ldsw = (unsigned)wid * 1024u;
    const int aoff = lds_byte(wr * 64 + fr, fq * 8), boff = lds_byte(wc * 32 + fr, fq * 8);
#define PG8_SA(b, h) (((b) * 2 + (h)) * HTB)
#define PG8_SB(b, h) ((4 + (b) * 2 + (h)) * HTB)
#define PG8_STAGE(bufoff, gbase, voff) do { _Pragma("unroll") for (int _i = 0; _i < 2; ++_i) \
        __builtin_amdgcn_global_load_lds((const unsigned*)((const char*)(gbase) + (voff)[_i]), (PG8_LAS unsigned*)(lds + (bufoff) + ldsw + _i * 8192), 16, 0, 0); } while (0)
#define PG8_LDA(dst, b, h) do { _Pragma("unroll") for (int m = 0; m < 4; ++m) _Pragma("unroll") for (int k = 0; k < 2; ++k) dst[m][k] = *(const PG8_LAS bf16x8*)(lds + PG8_SA(b, h) + aoff + m * 2048 + k * 1024); } while (0)
#define PG8_LDB(dst, b, h) do { _Pragma("unroll") for (int n = 0; n < 2; ++n) _Pragma("unroll") for (int k = 0; k < 2; ++k) dst[n][k] = *(const PG8_LAS bf16x8*)(lds + PG8_SB(b, h) + boff + n * 2048 + k * 1024); } while (0)
#define PG8_MMA(ai, bj, At, Bt) do { __builtin_amdgcn_s_setprio(1); _Pragma("unroll") for (int m = 0; m < 4; ++m) _Pragma("unroll") for (int n = 0; n < 2; ++n) _Pragma("unroll") for (int k = 0; k < 2; ++k) \
        acc[ai][bj][m][n] = __builtin_amdgcn_mfma_f32_16x16x32_bf16(Bt[n][k], At[m][k], acc[ai][bj][m][n], 0, 0, 0); __builtin_amdgcn_s_setprio(0); } while (0)
#define PG8_WAIT_V(n) asm volatile("s_waitcnt vmcnt(" #n ")" ::: "memory")
#define PG8_WAIT_L(n) asm volatile("s_waitcnt lgkmcnt(" #n ")" ::: "memory")
#define PG8_BAR __builtin_amdgcn_s_barrier()
#define PG8_SCHED __builtin_amdgcn_sched_barrier(0)
#define PG8_APTR(u) ((const char*)((u).seg == 0 ? g.A0 : ((u).seg == 1 ? g.A1 : g.A2)) + (size_t)(u).pm * tstep)
#define PG8_BPTR(u) ((const char*)((u).seg == 0 ? g.B0 : ((u).seg == 1 ? g.B1 : g.B2)) + (size_t)(u).pn * tstep)
    Unit cur, nxt; int ui = 0;
    if (!S.next(0, cur)) return;
    f32x4 acc[2][2][4][2];
#pragma unroll
    for (int a = 0; a < 2; ++a)
#pragma unroll
        for (int b = 0; b < 2; ++b)
#pragma unroll
            for (int m = 0; m < 4; ++m)
#pragma unroll
                for (int n = 0; n < 2; ++n) acc[a][b][m][n] = (f32x4){0.f, 0.f, 0.f, 0.f};
    bf16x8 At[4][2], B0[2][2], B1[2][2];
    const char* cA = PG8_APTR(cur); const char* cB = PG8_BPTR(cur);
    PG8_STAGE(PG8_SB(0, 0), cB, voffB); PG8_STAGE(PG8_SB(0, 1), cB + hstep, voffB); PG8_STAGE(PG8_SA(0, 0), cA, voffA); PG8_STAGE(PG8_SA(0, 1), cA + hstep, voffA);
    if (wr == 1) PG8_BAR;
    PG8_WAIT_V(2); PG8_BAR;
    PG8_STAGE(PG8_SB(1, 0), cB + kstep, voffB); PG8_STAGE(PG8_SA(1, 0), cA + kstep, voffA); PG8_STAGE(PG8_SB(1, 1), cB + hstep + kstep, voffB);
    PG8_WAIT_V(6); PG8_BAR;
    for (;;) {
        const bool has_next = S.next(ui + 1, nxt);
        const char* nA = has_next ? PG8_APTR(nxt) : cA; const char* nB = has_next ? PG8_BPTR(nxt) : cB;
        for (int t = 0; t < nt; t += 2) {
            const bool last = (t == nt - 2);
            const char* a1 = cA + (size_t)(t + 1) * kstep;
            const char* a2 = last ? nA : cA + (size_t)(t + 2) * kstep; const char* b2 = last ? nB : cB + (size_t)(t + 2) * kstep;
            const char* a3 = a2 + kstep; const char* b3 = b2 + kstep;
            PG8_LDB(B0, 0, 0); PG8_LDB(B1, 0, 1); PG8_SCHED; PG8_LDA(At, 0, 0); PG8_STAGE(PG8_SA(1, 1), a1 + hstep, voffA);
            PG8_WAIT_V(8); PG8_WAIT_L(0); PG8_BAR; PG8_MMA(0, 0, At, B0); PG8_MMA(0, 1, At, B1); PG8_BAR; PG8_SCHED;
            PG8_LDA(At, 0, 1); PG8_STAGE(PG8_SB(0, 0), b2, voffB); PG8_STAGE(PG8_SB(0, 1), b2 + hstep, voffB); PG8_STAGE(PG8_SA(0, 0), a2, voffA);
            PG8_WAIT_V(8); PG8_WAIT_L(0); PG8_BAR; PG8_MMA(1, 0, At, B0); PG8_MMA(1, 1, At, B1); PG8_BAR; PG8_SCHED;
            PG8_LDB(B0, 1, 0); PG8_LDB(B1, 1, 1); PG8_SCHED; PG8_LDA(At, 1, 0); PG8_STAGE(PG8_SA(0, 1), a2 + hstep, voffA);
            PG8_WAIT_V(8); PG8_WAIT_L(0); PG8_BAR; PG8_MMA(0, 0, At, B0); PG8_MMA(0, 1, At, B1); PG8_BAR; PG8_SCHED;
            PG8_LDA(At, 1, 1); PG8_STAGE(PG8_SB(1, 0), b3, voffB); PG8_STAGE(PG8_SB(1, 1), b3 + hstep, voffB); PG8_STAGE(PG8_SA(1, 0), a3, voffA);
            PG8_WAIT_V(8); PG8_WAIT_L(0); PG8_BAR; PG8_MMA(1, 0, At, B0); PG8_MMA(1, 1, At, B1); PG8_BAR; PG8_SCHED;
        }
        if (wr == 0) PG8_BAR;
        const bool rst = E.apply(acc, cur, wr, wc, fr, fq);
        if (!has_next) break;
        if (rst) {
#pragma unroll
        for (int a = 0; a < 2; ++a)
#pragma unroll
            for (int b = 0; b < 2; ++b)
#pragma unroll
                for (int m = 0; m < 4; ++m)
#pragma unroll
                    for (int n = 0; n < 2; ++n) acc[a][b][m][n] = (f32x4){0.f, 0.f, 0.f, 0.f};
        }
        cur = nxt; cA = nA; cB = nB; ++ui;
        if (wr == 1) PG8_BAR;
    }
    PG8_WAIT_V(0);
    PG8_BAR;
#undef PG8_SA
#undef PG8_SB
#undef PG8_STAGE
#undef PG8_LDA
#undef PG8_LDB
#undef PG8_MMA
#undef PG8_WAIT_V
#undef PG8_WAIT_L
#undef PG8_BAR
#undef PG8_SCHED
#undef PG8_APTR
#undef PG8_BPTR
}
}
#define EPI_LOOP_BEGIN \
    _Pragma("unroll") for (int ai = 0; ai < 2; ++ai) _Pragma("unroll") for (int m = 0; m < 4; ++m) { \
        const int row = u.pm * 256 + ai * 128 + wr * 64 + m * 16 + fr; \
        _Pragma("unroll") for (int bj = 0; bj < 2; ++bj) { const int col = u.pn * 256 + bj * 128 + wc * 32 + 8 * fq; \
            f32x4 v0 = acc[ai][bj][m][0], v1 = acc[ai][bj][m][1];
#define EPI_LOOP_END } }

struct EpiProj {
    bf16_t* O; bf16_t* VBT; bf16_t* VTT; float* ST; const float* rope; int pn_off; const float* ssq; bf16_t* UA; const LAS float* nrm_lds; int pm0;
    __device__ __forceinline__ bool apply(f32x4 (&acc)[2][2][4][2], const pg8::Unit& u, int wr, int wc, int fr, int fq) const {
        const int pn = u.pn + pn_off;
        const int act = (pn < 4) ? 0 : (pn < 8) ? 1 : (pn < 16) ? 2 : (pn < 20) ? 1 : (pn < 25) ? 0 : (pn < 29) ? 1 : 3;
        const bool is_vb = (pn >= 12) && (pn < 16), is_q = (pn >= 20) && (pn < 24), is_kv = (pn == 24);
        const bool rot_lane = ((wc & 1) == 0) && (fq < 2);
        const float sg = (fq == 0) ? -1.f : 1.f;
#pragma unroll
        for (int ai = 0; ai < 2; ++ai)
#pragma unroll
            for (int m = 0; m < 4; ++m) {
                const int row = u.pm * 256 + ai * 128 + wr * 64 + m * 16 + fr;
                const float nrm = (u.pm == pm0) ? nrm_lds[ai * 128 + wr * 64 + m * 16 + fr] : 1.0f / sqrtf(ssq[row] * (1.0f / DM) + EPS);
                float rs = 0.f, rss = 0.f;
#pragma unroll
                for (int bj = 0; bj < 2; ++bj) {
                    const int col = pn * 256 + bj * 128 + wc * 32 + 8 * fq;
                    const f32x4 v0 = acc[ai][bj][m][0], v1 = acc[ai][bj][m][1];
                    float f[8] = {v0[0] * nrm, v0[1] * nrm, v0[2] * nrm, v0[3] * nrm, v1[0] * nrm, v1[1] * nrm, v1[2] * nrm, v1[3] * nrm};
                    if (act == 1) { _Pragma("unroll") for (int e = 0; e < 8; ++e) f[e] = silu_f(f[e]); }
                    else if (act == 2) { _Pragma("unroll") for (int e = 0; e < 8; ++e) f[e] = gelu_f(f[e]); }
                    else if (act == 3) { _Pragma("unroll") for (int e = 0; e < 8; ++e) f[e] = sigm(f[e]); }
                    if (is_q || (is_kv && bj == 0)) {
                        float o[8];
                        _Pragma("unroll") for (int e = 0; e < 8; ++e) o[e] = __shfl_xor(f[e], 16);
                        if (rot_lane) { const f32x4* rp = (const f32x4*)(rope + (row & 2047) * 16);
                            const f32x4 c0 = rp[0], c1 = rp[1], c2 = rp[2], c3 = rp[3];
                            const float cs[16] = {c0[0], c0[1], c0[2], c0[3], c1[0], c1[1], c1[2], c1[3], c2[0], c2[1], c2[2], c2[3], c3[0], c3[1], c3[2], c3[3]};
                            _Pragma("unroll") for (int e = 0; e < 8; ++e) f[e] = f[e] * cs[2 * e] + sg * o[e] * cs[2 * e + 1]; }
                        if (is_q) { _Pragma("unroll") for (int e = 0; e < 8; ++e) f[e] *= 0.125f; }
                    }
                    if (is_vb) {
                        _Pragma("unroll") for (int e = 0; e < 8; ++e) { rs += f[e]; rss += f[e] * f[e]; }
                        bf16_t* dst = VBT + ((size_t)(row >> 7) * 1024 + (col - C_VB)) * 128 + (row & 127);
                        _Pragma("unroll") for (int e = 0; e < 8; ++e) dst[e * 128] = (bf16_t)f2bf(f[e]);
                    } else if (is_kv && bj == 1) {
                        bf16_t* dst = VTT + ((size_t)((row >> 11) * 2 + (wc >> 1)) * 64 + (wc & 1) * 32 + 8 * fq) * 2048 + (row & 2047);
                        _Pragma("unroll") for (int e = 0; e < 8; ++e) dst[e * 2048] = (bf16_t)f2bf(f[e]);
                    } else {
                        u32x4 w; w.x = cvt_pk_bf16(f[0], f[1]); w.y = cvt_pk_bf16(f[2], f[3]); w.z = cvt_pk_bf16(f[4], f[5]); w.w = cvt_pk_bf16(f[6], f[7]);
                        if (pn < 4) *(u32x4*)(UA + ((size_t)(col >> 4) * NTOK + row) * 16 + (col & 15)) = w;
                        else __builtin_nontemporal_store(w, (u32x4*)(O + (size_t)row * DIN + col));
                    }
                }
                if (is_vb) {
                    rs += __shfl_xor(rs, 16); rs += __shfl_xor(rs, 32); rss += __shfl_xor(rss, 16); rss += __shfl_xor(rss, 32);
                    if (fq == 0) { unsafeAtomicAdd(ST + row * 2, rs); unsafeAtomicAdd(ST + row * 2 + 1, rss); }
                }
            }
        return true;
    }
};
struct EpiGlu {
    const float* bias; const bf16_t* ya0; const bf16_t* proj; bf16_t* O;
    __device__ __forceinline__ bool apply(f32x4 (&acc)[2][2][4][2], const pg8::Unit& u, int wr, int wc, int fr, int fq) const {
        EPI_LOOP_BEGIN
            const f32x4 b0 = *(const f32x4*)(bias + col), b1 = *(const f32x4*)(bias + col + 4);
            float f[8] = {v0[0] + b0[0], v0[1] + b0[1], v0[2] + b0[2], v0[3] + b0[3], v1[0] + b1[0], v1[1] + b1[1], v1[2] + b1[2], v1[3] + b1[3]};
            float y[8], z[8];
            unpack8(*(const u32x4*)(ya0 + (size_t)row * 1024 + col), y);
            unpack8(*(const u32x4*)(proj + (size_t)row * DIN + C_ZA + col), z);
            _Pragma("unroll") for (int e = 0; e < 8; ++e) f[e] = y[e] * sigm(f[e]) * z[e];
            u32x4 w; w.x = cvt_pk_bf16(f[0], f[1]); w.y = cvt_pk_bf16(f[2], f[3]); w.z = cvt_pk_bf16(f[4], f[5]); w.w = cvt_pk_bf16(f[6], f[7]);
            *(u32x4*)(O + (size_t)row * 1024 + col) = w;
        EPI_LOOP_END
        return true;
    }
};
struct EpiMerge {
    const bf16_t* proj; bf16_t* O;
    __device__ __forceinline__ bool apply(f32x4 (&acc)[2][2][4][2], const pg8::Unit& u, int wr, int wc, int fr, int fq) const {
        const int seg = u.seg;
        EPI_LOOP_BEGIN
            float f[8] = {v0[0], v0[1], v0[2], v0[3], v1[0], v1[1], v1[2], v1[3]};
            const bf16_t* gp = proj + (size_t)row * DIN + C_G + col;
            if (seg < 2) {
                float gn[8], gd[8];
                unpack8(*(const u32x4*)(gp + seg * 2048), gn);
                unpack8(*(const u32x4*)(gp + (seg + 1) * 2048), gd);
                _Pragma("unroll") for (int e = 0; e < 8; ++e) f[e] = f[e] * (gn[e] * __builtin_amdgcn_rcpf(fmaxf(gd[e], 1e-30f)));
                acc[ai][bj][m][0] = (f32x4){f[0], f[1], f[2], f[3]}; acc[ai][bj][m][1] = (f32x4){f[4], f[5], f[6], f[7]};
            } else {
                float gn[8];
                unpack8(*(const u32x4*)(gp + 2 * 2048), gn);
                _Pragma("unroll") for (int e = 0; e < 8; ++e) f[e] = f[e] * gn[e];
                u32x4 w; w.x = cvt_pk_bf16(f[0], f[1]); w.y = cvt_pk_bf16(f[2], f[3]); w.z = cvt_pk_bf16(f[4], f[5]); w.w = cvt_pk_bf16(f[6], f[7]);
                *(u32x4*)(O + (size_t)row * DM + col) = w;
            }
        EPI_LOOP_END
        return seg == 2;
    }
};
struct EpiOut {
    const float* xin; float* xout; bf16_t* xn; const float* wn; float* ssq;
    __device__ __forceinline__ bool apply(f32x4 (&acc)[2][2][4][2], const pg8::Unit& u, int wr, int wc, int fr, int fq) const {
#pragma unroll
        for (int ai = 0; ai < 2; ++ai)
#pragma unroll
            for (int m = 0; m < 4; ++m) {
                const int row = u.pm * 256 + ai * 128 + wr * 64 + m * 16 + fr;
                float q = 0.f;
#pragma unroll
                for (int bj = 0; bj < 2; ++bj) {
                    const int col = u.pn * 256 + bj * 128 + wc * 32 + 8 * fq;
                    const size_t o = (size_t)row * DM + col;
                    const f32x4 x0 = *(const f32x4*)(xin + o) + acc[ai][bj][m][0], x1 = *(const f32x4*)(xin + o + 4) + acc[ai][bj][m][1];
                    *(f32x4*)(xout + o) = x0; *(f32x4*)(xout + o + 4) = x1;
                    if (xn) {
                        const f32x4 w0 = *(const f32x4*)(wn + col), w1 = *(const f32x4*)(wn + col + 4);
                        q += (x0[0] * x0[0] + x0[1] * x0[1]) + (x0[2] * x0[2] + x0[3] * x0[3]) + (x1[0] * x1[0] + x1[1] * x1[1]) + (x1[2] * x1[2] + x1[3] * x1[3]);
                        u32x4 w; w.x = cvt_pk_bf16(x0[0] * w0[0], x0[1] * w0[1]); w.y = cvt_pk_bf16(x0[2] * w0[2], x0[3] * w0[3]);
                        w.z = cvt_pk_bf16(x1[0] * w1[0], x1[1] * w1[1]); w.w = cvt_pk_bf16(x1[2] * w1[2], x1[3] * w1[3]);
                        *(u32x4*)(xn + o) = w;
                    }
                }
                if (xn) { q += __shfl_xor(q, 16); q += __shfl_xor(q, 32); if (fq == 0) unsafeAtomicAdd(ssq + row, q); }
            }
        return true;
    }
};
struct KParams { const float* in[23]; float* out; unsigned char* ws; };

__device__ __forceinline__ void p0_transpose_item(const float* W, int K, int N, bf16_t* WT, LAS unsigned char* scr, int item, int lane) {
    const int nblk = N / 64, kb = item / nblk, nb = item - kb * nblk, k0 = 64 * kb, n0 = 64 * nb;
    f32x4 v[16];
    const float* src = W + (size_t)(k0 + (lane >> 4)) * N + n0 + 4 * (lane & 15);
#pragma unroll
    for (int i = 0; i < 16; ++i) v[i] = __builtin_nontemporal_load((const f32x4*)(src + (size_t)(4 * i) * N));
#pragma unroll
    for (int i = 0; i < 16; ++i) { const int kk = (lane >> 4) + 4 * i; LAS bf16_t* d = (LAS bf16_t*)scr + (4 * (lane & 15)) * 66 + kk;
        d[0] = (bf16_t)f2bf(v[i][0]); d[66] = (bf16_t)f2bf(v[i][1]); d[132] = (bf16_t)f2bf(v[i][2]); d[198] = (bf16_t)f2bf(v[i][3]); }
    asm volatile("s_waitcnt lgkmcnt(0)" ::: "memory");
    const int c = lane & 7;
#pragma unroll
    for (int j = 0; j < 8; ++j) { const int n = (lane >> 3) + 8 * j; const LAS unsigned* s = (const LAS unsigned*)(scr + n * 132 + c * 16);
        u32x4 o; o.x = s[0]; o.y = s[1]; o.z = s[2]; o.w = s[3];
        *(u32x4*)(WT + (size_t)(n0 + n) * K + k0 + 8 * c) = o; }
    asm volatile("s_waitcnt lgkmcnt(0)" ::: "memory");
}
__device__ __forceinline__ void xw_row_bf16(const float* xrow, const float* w, bf16_t* orow, float* ssq_out, int lane) {
    const f32x4* xr = (const f32x4*)xrow + lane; const f32x4* wr = (const f32x4*)w + lane;
    f32x4 v[8]; float s = 0.f;
#pragma unroll
    for (int j = 0; j < 8; ++j) { v[j] = xr[64 * j]; s += (v[j].x * v[j].x + v[j].y * v[j].y) + (v[j].z * v[j].z + v[j].w * v[j].w); }
    s = wave_sum(s);
    if (lane == 0) *ssq_out = s;
    u32x2* o8 = (u32x2*)orow + lane;
#pragma unroll
    for (int j = 0; j < 8; ++j) { const f32x4 ww = wr[64 * j]; u32x2 o; o.x = pk2(v[j].x * ww.x, v[j].y * ww.y); o.y = pk2(v[j].z * ww.z, v[j].w * ww.w); o8[64 * j] = o; }
}
__device__ __forceinline__ void rms_row_f32(const float* xrow, const float* w, float* orow, int lane) {
    const f32x4* xr = (const f32x4*)xrow + lane; const f32x4* wr = (const f32x4*)w + lane;
    f32x4 v[8]; float s = 0.f;
#pragma unroll
    for (int j = 0; j < 8; ++j) { v[j] = xr[64 * j]; s += (v[j].x * v[j].x + v[j].y * v[j].y) + (v[j].z * v[j].z + v[j].w * v[j].w); }
    const float rs = 1.0f / sqrtf(wave_sum(s) * (1.0f / DM) + EPS);
    f32x4* o = (f32x4*)orow + lane;
#pragma unroll
    for (int j = 0; j < 8; ++j) { const f32x4 ww = wr[64 * j]; __builtin_nontemporal_store(v[j] * rs * ww, o + 64 * j); }
}

__device__ __forceinline__ void s5_tables_item(const KParams& P, LAS unsigned char* lds, int l, int g) {
    const int tid = launder((int)threadIdx.x);
    LAS float* LPre = (LAS float*)lds; LAS float* LPim = LPre + 64 * 68; LAS float* LTre = LPim + 64 * 68; LAS float* LTim = LTre + 65 * 64;
    LAS float* BBre = LTim + 65 * 64; LAS float* BBim = BBre + 1024; LAS float* CCre = BBim + 1024; LAS float* CCim = CCre + 1024;
    const float* a_re = P.in[3] + (size_t)(l * 64 + g) * 64; const float* a_im = P.in[4] + (size_t)(l * 64 + g) * 64;
    const float* b_re = P.in[6] + (size_t)(l * 64 + g) * 1024; const float* b_im = P.in[7] + (size_t)(l * 64 + g) * 1024;
    const float* c_re = P.in[8] + (size_t)(l * 64 + g) * 1024; const float* c_im = P.in[9] + (size_t)(l * 64 + g) * 1024;
    bf16_t* KT = (bf16_t*)(P.ws + OFF_KT + (size_t)l * SZ_KT) + (size_t)g * 65 * 256;
    bf16_t* Eg = (bf16_t*)(P.ws + OFF_E + (size_t)l * SZ_E) + (size_t)g * 128 * 1024;
    bf16_t* Fg = (bf16_t*)(P.ws + OFF_F + (size_t)l * SZ_F) + (size_t)g * 1024 * 128;
    float* L64 = (float*)(P.ws + OFF_L64 + (size_t)l * SZ_L64) + (size_t)g * 128;
    if (tid < 64) {
        const int p = tid;
        const double dt = exp_d((double)P.in[5][l * 64 + g]);
        const double are = (double)a_re[p], aim = (double)a_im[p];
        const double zr = are * dt, zi = aim * dt;
        double sn, cs; sincos_d(zi, sn, cs);
        const double ez = exp_d(zr);
        const double lbr = ez * cs, lbi = ez * sn;
        double qr, qi;
        if (zr * zr + zi * zi < 0.25) {
            double tr = 1.0, ti = 0.0; qr = 1.0; qi = 0.0;
#pragma unroll
            for (int k = 1; k <= 20; ++k) { const double rk = 1.0 / (double)(k + 1); const double nr = (tr * zr - ti * zi) * rk, ni = (tr * zi + ti * zr) * rk; tr = nr; ti = ni; qr += tr; qi += ti; }
        } else {
            const double nr = lbr - 1.0, ni = lbi, den = 1.0 / (zr * zr + zi * zi);
            qr = (nr * zr + ni * zi) * den; qi = (ni * zr - nr * zi) * den;
        }
        const double cr = qr * dt, ci = qi * dt;
#pragma unroll 4
        for (int c = 0; c < 16; ++c) { const double br = (double)b_re[p * 16 + c], bi = (double)b_im[p * 16 + c];
            BBre[p * 16 + c] = (float)(cr * br - ci * bi); BBim[p * 16 + c] = (float)(cr * bi + ci * br); }
        double pr = 1.0, pi = 0.0;
        for (int k = 0; k <= 64; ++k) { const float fr_ = (float)pr, fi_ = (float)pi; LPre[p * 68 + k] = fr_; LPim[p * 68 + k] = fi_; LTre[k * 64 + p] = fr_; LTim[k * 64 + p] = fi_;
            if (k == 64) { L64[p * 2 + 0] = fr_; L64[p * 2 + 1] = fi_; }
            const double nr = pr * lbr - pi * lbi, ni = pr * lbi + pi * lbr; pr = nr; pi = ni; }
    }
    for (int i = tid; i < 1024; i += 512) { CCre[i] = c_re[i]; CCim[i] = c_im[i]; }
    __syncthreads();
    {
        const int pair = tid & 255, c = pair >> 4, cp = pair & 15, half = tid >> 8;
        f32x4 a[8];
#pragma unroll
        for (int i = 0; i < 8; ++i) a[i] = (f32x4){0.f, 0.f, 0.f, 0.f};
#pragma unroll 2
        for (int p = 0; p < 64; ++p) {
            const float xr = CCre[c * 64 + p], xi = CCim[c * 64 + p], yr = BBre[p * 16 + cp], yi = BBim[p * 16 + cp];
            const float cbr = xr * yr - xi * yi, cbi = xr * yi + xi * yr;
#pragma unroll
            for (int i = 0; i < 8; ++i) { const f32x4 lr = *(LAS f32x4*)(LPre + p * 68 + half * 32 + 4 * i), li = *(LAS f32x4*)(LPim + p * 68 + half * 32 + 4 * i); a[i] += cbr * lr - cbi * li; }
        }
#pragma unroll
        for (int i = 0; i < 32; ++i) KT[(size_t)(half * 32 + i + 1) * 256 + pair] = (bf16_t)f2bf(a[i >> 2][i & 3]);
        if (tid < 256) KT[tid] = 0;
    }
    for (int j = 0; j < 16; ++j) {
        const int id = tid + 512 * j, pp = id >> 6, s = id & 63, p = pp & 63, ri = pp >> 6;
        const float lr = LPre[p * 68 + 63 - s], li = LPim[p * 68 + 63 - s];
        const float m0 = ri ? li : lr, m1 = ri ? lr : -li;
        unsigned o[8];
#pragma unroll
        for (int q4 = 0; q4 < 4; ++q4) { const f32x4 yr = *(LAS f32x4*)(BBre + p * 16 + 4 * q4), yi = *(LAS f32x4*)(BBim + p * 16 + 4 * q4);
            o[2 * q4] = pk2(m0 * yr[0] + m1 * yi[0], m0 * yr[1] + m1 * yi[1]); o[2 * q4 + 1] = pk2(m0 * yr[2] + m1 * yi[2], m0 * yr[3] + m1 * yi[3]); }
        u32x4* dst = (u32x4*)(Eg + ((size_t)((pp >> 4) * 32 + (s >> 1)) * 64 + (s & 1) * 32 + (pp & 15)) * 8);
        dst[0] = (u32x4){o[0], o[1], o[2], o[3]}; dst[16] = (u32x4){o[4], o[5], o[6], o[7]};
    }
    for (int j = 0; j < 16; ++j) {
        const int id = tid + 512 * j, pq = id & 3, ri = (id >> 2) & 1, tc = id >> 3, t = tc >> 4, c = tc & 15, p0 = pq * 16;
        unsigned o[8];
#pragma unroll
        for (int q4 = 0; q4 < 4; ++q4) { const f32x4 xr = *(LAS f32x4*)(CCre + c * 64 + p0 + 4 * q4), xi = *(LAS f32x4*)(CCim + c * 64 + p0 + 4 * q4);
            const f32x4 lr = *(LAS f32x4*)(LTre + (t + 1) * 64 + p0 + 4 * q4), li = *(LAS f32x4*)(LTim + (t + 1) * 64 + p0 + 4 * q4);
            const f32x4 v = ri ? -(xr * li + xi * lr) : (xr * lr - xi * li);
            o[2 * q4] = pk2(v[0], v[1]); o[2 * q4 + 1] = pk2(v[2], v[3]); }
        const int pp0 = ri * 64 + p0;
        u32x4* dst = (u32x4*)(Fg + ((size_t)(((t & 7) * 4 + (pp0 >> 5)) * 8 + (t >> 3)) * 64 + ((pp0 & 31) >> 3) * 16 + c) * 8);
        dst[0] = (u32x4){o[0], o[1], o[2], o[3]}; dst[16] = (u32x4){o[4], o[5], o[6], o[7]};
    }
    __syncthreads();
}
__device__ __forceinline__ void rope_item(const KParams& P, int item) {
    const int e = item * 512 + threadIdx.x, pos = e >> 3, i = e & 7;
    const float inv = (float)exp_d(-(double)i * 0.125 * 13.122363377404328);
    const float ang = (float)pos * inv;
    double s, c; sincos_d((double)ang, s, c);
    float* R = (float*)(P.ws + OFF_ROPE);
    R[e * 2 + 0] = (float)c; R[e * 2 + 1] = (float)s;
}
constexpr int I_IN = (DM / 64) * (DIN / 64), I_GLU = (1024 / 64) * (1024 / 64), I_BR = (1024 / 64) * (2048 / 64), I_OUT = (2048 / 64) * (2048 / 64);
constexpr int PER_L = I_IN + I_GLU + 3 * I_BR + I_OUT;
#define TR_WINDOW(G) 0
__device__ __forceinline__ void p0_transpose_dispatch(const KParams& P, LAS unsigned char* scr, int it, int lane) {
    const int l = it / PER_L; int r = it - l * PER_L;
    if (r < I_IN) { p0_transpose_item(P.in[2] + (size_t)l * DM * DIN, DM, DIN, (bf16_t*)(P.ws + OFF_WIN + l * SZ_WIN), scr, r, lane); return; } r -= I_IN;
    if (r < I_GLU) { p0_transpose_item(P.in[11] + (size_t)l * 1024 * 1024, 1024, 1024, (bf16_t*)(P.ws + OFF_GLU + l * SZ_GLU), scr, r, lane); return; } r -= I_GLU;
    if (r < 3 * I_BR) { const int br = r / I_BR; r -= br * I_BR;
        const float* W = (br == 0 ? P.in[18] : br == 1 ? P.in[19] : P.in[20]) + (size_t)l * 1024 * 2048;
        p0_transpose_item(W, 1024, 2048, (bf16_t*)(P.ws + OFF_WBR + (size_t)(l * 3 + br) * SZ_WBR), scr, r, lane); return; } r -= 3 * I_BR;
    p0_transpose_item(P.in[21] + (size_t)l * 2048 * 2048, 2048, 2048, (bf16_t*)(P.ws + OFF_WOUT + l * SZ_WOUT), scr, r, lane);
}
__device__ __forceinline__ void p0_prologue(const KParams& P, LAS unsigned char* lds) {
    const int tid = launder((int)threadIdx.x), lane = tid & 63, wave = __builtin_amdgcn_readfirstlane(tid >> 6), G = gridDim.x;
    for (int it = blockIdx.x; it < 32; it += G) rope_item(P, it);
    __syncthreads();
    LAS unsigned char* scr = lds + wave * 16384;
    const int gw = blockIdx.x * 8 + wave, NGW = G * 8;
    for (int it = gw; it < 2 * PER_L - TR_WINDOW(G); it += NGW) p0_transpose_dispatch(P, scr, it, lane);
    for (int i = blockIdx.x * 512 + tid; i < 2 * NTOK * 2; i += G * 512) ((float*)(P.ws + OFF_ST))[i] = 0.f;
    for (int i = blockIdx.x * 512 + tid; i < NTOK; i += G * 512) ((float*)(P.ws + OFF_SSQ))[NTOK + i] = 0.f;
    for (int m = gw; m < NTOK; m += NGW) xw_row_bf16(P.in[0] + (size_t)m * DM, P.in[1], (bf16_t*)(P.ws + OFF_XN) + (size_t)m * DM, (float*)(P.ws + OFF_SSQ) + m, lane);
    __syncthreads();
}
#define MFMA16(a, b, c) __builtin_amdgcn_mfma_f32_16x16x32_bf16((a), (b), (c), 0, 0, 0)
__device__ __forceinline__ bf16x8 lds16(LAS unsigned char* p) { return *(LAS bf16x8*)p; }
__device__ __forceinline__ bf16x8 cat8(s16x4 a, s16x4 b) { return (bf16x8){a[0], a[1], a[2], a[3], b[0], b[1], b[2], b[3]}; }

template <int I0>
__device__ __forceinline__ void toep_seg(f32x4 (&acc)[8][2], LAS unsigned char* up, LAS unsigned char* kp, int w, int fq, int kk_lo, int kk_hi) {
#pragma unroll 1
    for (int kk = kk_lo; kk <= kk_hi; ++kk) {
        const bf16x8 b0 = lds16(up + kk * 64), b1 = lds16(up + 16 * 2064 + kk * 64);
        LAS unsigned char* kb = kp + (w - 2 * kk - (fq >> 1) + 1) * 512;
#pragma unroll
        for (int i4 = I0; i4 < 8; i4 += 4) {
            bf16x8 a[4];
#pragma unroll
            for (int d = 0; d < 4; ++d) if (i4 + d < 8) a[d] = lds16(kb + (i4 + d) * 8 * 512);
#pragma unroll
            for (int d = 0; d < 4; ++d) if (i4 + d < 8) { acc[i4 + d][0] = MFMA16(a[d], b0, acc[i4 + d][0]); acc[i4 + d][1] = MFMA16(a[d], b1, acc[i4 + d][1]); }
        }
    }
}
constexpr int S5_U = 0, S5_UROW = 2064, S5_KT = 66048, S5_S = 99328, S5_XP = 116224, S5_XPROW = 272;
__device__ __forceinline__ void s5_item(const KParams& P, LAS unsigned char* lds, int l, int b, int g) {
    const int tid = launder((int)threadIdx.x), lane = tid & 63, w = __builtin_amdgcn_readfirstlane(tid >> 6), fr = lane & 15, fq = lane >> 4;
    const bf16_t* proj = (const bf16_t*)(P.ws + OFF_PROJ);
    const bf16_t* KTg = (const bf16_t*)(P.ws + OFF_KT + (size_t)l * SZ_KT) + (size_t)g * 65 * 256;
    const bf16_t* Eg = (const bf16_t*)(P.ws + OFF_E + (size_t)l * SZ_E) + (size_t)g * 128 * 1024;
    const bf16_t* Fg = (const bf16_t*)(P.ws + OFF_F + (size_t)l * SZ_F) + (size_t)g * 1024 * 128;
    const float* L64 = (const float*)(P.ws + OFF_L64 + (size_t)l * SZ_L64) + (size_t)g * 128;
    bf16_t* ya0 = (bf16_t*)(P.ws + OFF_YA0);
    bf16x8 ef[32];
    {
        const bf16_t* ep = Eg + ((size_t)(w * 32) * 64 + lane) * 8;
#pragma unroll
        for (int kk = 0; kk < 32; ++kk) ef[kk] = *(const bf16x8*)(ep + kk * 512);
    }
#pragma unroll
    for (int i = 0; i < 4; ++i) { const int t = tid + 512 * i; const u32x4* src = (const u32x4*)((const bf16_t*)(P.ws + OFF_UA) + ((size_t)g * NTOK + b * SEQ + t) * 16);
        const u32x4 v0 = src[0], v1 = src[1]; LAS u32x4* dst = (LAS u32x4*)(lds + S5_U + (t >> 6) * S5_UROW + (t & 63) * 32); dst[0] = v0; dst[1] = v1; }
    for (int i = tid; i < 2080; i += 512) ((LAS u32x4*)(lds + S5_KT))[i] = ((const u32x4*)KTg)[i];
    __syncthreads();
    {
        f32x4 a0 = {0.f, 0.f, 0.f, 0.f}, a1 = {0.f, 0.f, 0.f, 0.f};
        LAS unsigned char* up = lds + S5_U + fr * S5_UROW + fq * 16;
#pragma unroll
        for (int kk = 0; kk < 32; ++kk) {
            const bf16x8 b0 = lds16(up + kk * 64), b1 = lds16(up + 16 * S5_UROW + kk * 64);
            a0 = MFMA16(ef[kk], b0, a0); a1 = MFMA16(ef[kk], b1, a1);
        }
        LAS float* S = (LAS float*)(lds + S5_S);
#pragma unroll
        for (int r = 0; r < 4; ++r) { S[(16 * w + fq * 4 + r) * 33 + fr] = a0[r]; S[(16 * w + fq * 4 + r) * 33 + 16 + fr] = a1[r]; }
    }
    bf16x8 ff[4][8];
#pragma unroll
    for (int kk = 0; kk < 4; ++kk)
#pragma unroll
        for (int i = 0; i < 8; ++i) ff[kk][i] = *(const bf16x8*)(Fg + ((size_t)((w * 4 + kk) * 8 + i) * 64 + lane) * 8);
    __syncthreads();
    if (tid < 64) {
        const int p = tid; const float lr = L64[p * 2], li = L64[p * 2 + 1];
        LAS float* S = (LAS float*)(lds + S5_S);
        float sr[32], si[32];
#pragma unroll
        for (int j = 0; j < 32; ++j) { sr[j] = S[p * 33 + j]; si[j] = S[(64 + p) * 33 + j]; }
        float xr = 0.f, xi = 0.f;
#pragma unroll
        for (int j = 0; j < 32; ++j) {
            LAS bf16_t* xp = (LAS bf16_t*)(lds + S5_XP + j * S5_XPROW);
            xp[p] = (bf16_t)f2bf(xr); xp[64 + p] = (bf16_t)f2bf(xi);
            const float nr = lr * xr - li * xi + sr[j], ni = lr * xi + li * xr + si[j]; xr = nr; xi = ni;
        }
    }
    __syncthreads();
    {
        f32x4 acc[8][2];
#pragma unroll
        for (int i = 0; i < 8; ++i) { acc[i][0] = (f32x4){0.f, 0.f, 0.f, 0.f}; acc[i][1] = (f32x4){0.f, 0.f, 0.f, 0.f}; }
        LAS unsigned char* up = lds + S5_U + fr * S5_UROW + fq * 16;
        LAS unsigned char* kp = lds + S5_KT + fr * 32 + (fq & 1) * 16;
        toep_seg<0>(acc, up, kp, w, fq, 0, w >> 1);
        toep_seg<1>(acc, up, kp, w, fq, (w >> 1) + 1, (w + 8) >> 1);
        toep_seg<2>(acc, up, kp, w, fq, ((w + 8) >> 1) + 1, (w + 16) >> 1);
        toep_seg<3>(acc, up, kp, w, fq, ((w + 16) >> 1) + 1, (w + 24) >> 1);
        toep_seg<4>(acc, up, kp, w, fq, ((w + 24) >> 1) + 1, (w + 32) >> 1);
        toep_seg<5>(acc, up, kp, w, fq, ((w + 32) >> 1) + 1, (w + 40) >> 1);
        toep_seg<6>(acc, up, kp, w, fq, ((w + 40) >> 1) + 1, (w + 48) >> 1);
        toep_seg<7>(acc, up, kp, w, fq, ((w + 48) >> 1) + 1, (w + 56) >> 1);
        LAS unsigned char* xp = lds + S5_XP + fr * S5_XPROW + fq * 16;
#pragma unroll
        for (int kk = 0; kk < 4; ++kk) {
            const bf16x8 b0 = lds16(xp + kk * 64), b1 = lds16(xp + 16 * S5_XPROW + kk * 64);
#pragma unroll
            for (int i = 0; i < 8; ++i) { acc[i][0] = MFMA16(ff[kk][i], b0, acc[i][0]); acc[i][1] = MFMA16(ff[kk][i], b1, acc[i][1]); }
        }
        const f32x4 dv = *(const f32x4*)(P.in[10] + (size_t)l * 1024 + g * 16 + fq * 4);
#pragma unroll
        for (int i = 0; i < 8; ++i)
#pragma unroll
            for (int nt = 0; nt < 2; ++nt) { const int t = w + 8 * i, j = nt * 16 + fr;
                const u32x2 uu = *(LAS u32x2*)(lds + S5_U + j * S5_UROW + t * 32 + fq * 8);
                const float y0 = gelu_f(acc[i][nt][0] + dv[0] * bflo(uu.x)), y1 = gelu_f(acc[i][nt][1] + dv[1] * bfhi(uu.x));
                const float y2 = gelu_f(acc[i][nt][2] + dv[2] * bflo(uu.y)), y3 = gelu_f(acc[i][nt][3] + dv[3] * bfhi(uu.y));
                u32x2 o; o.x = cvt_pk_bf16(y0, y1); o.y = cvt_pk_bf16(y2, y3);
                *(u32x2*)(ya0 + (size_t)(b * SEQ + j * 64 + t) * 1024 + g * 16 + fq * 4) = o; }
    }
    __syncthreads();
}

constexpr int SG_ST = 0, SG_R = 1024, SG_W = 2048, SG_ROW = 272;
__device__ __forceinline__ void sg_item(const KParams& P, LAS unsigned char* lds, int l, int chunk, int h) {
    const int tid = launder((int)threadIdx.x), lane = tid & 63, w = __builtin_amdgcn_readfirstlane(tid >> 6), fr = lane & 15, fq = lane >> 4;
    const bf16_t* proj = (const bf16_t*)(P.ws + OFF_PROJ);
    const int tok0 = chunk * 128;
    LAS float* ST = (LAS float*)(lds + SG_ST); LAS float* R = (LAS float*)(lds + SG_R);
    const bf16_t* vbt = (const bf16_t*)(P.ws + OFF_VBT) + ((size_t)chunk * 1024 + h * 128 + 16 * w + fr) * 128 + fq * 8;
    bf16x8 af[4];
#pragma unroll
    for (int kk = 0; kk < 4; ++kk) af[kk] = *(const bf16x8*)(vbt + kk * 32);
    const float* Wg = P.in[15] + (size_t)(l * 8 + h) * 16384;
    f32x4 wx[8];
#pragma unroll
    for (int i = 0; i < 8; ++i) { const int idx = tid + 512 * i; wx[i] = *(const f32x4*)(Wg + (idx >> 5) * 128 + (idx & 31) * 4); }
    if (tid < 128) { const float* st = (const float*)(P.ws + OFF_ST) + (size_t)l * NTOK * 2 + (size_t)(tok0 + tid) * 2;
        const float mean = st[0] * (1.0f / 1024.0f), var = fmaxf(st[1] * (1.0f / 1024.0f) - mean * mean, 0.f);
        ST[tid * 2] = mean; ST[tid * 2 + 1] = 1.0f / sqrtf(var + EPS); }
    __syncthreads();
#pragma unroll
    for (int i = 0; i < 8; ++i) { const int idx = tid + 512 * i, t = idx >> 5, s4 = (idx & 31) * 4; const f32x4 x = wx[i];
        const f32x4 m0 = *(LAS f32x4*)(ST + s4 * 2), m1 = *(LAS f32x4*)(ST + s4 * 2 + 4);
        const float x0 = s4 <= t ? x[0] : 0.f, x1 = s4 + 1 <= t ? x[1] : 0.f, x2 = s4 + 2 <= t ? x[2] : 0.f, x3 = s4 + 3 <= t ? x[3] : 0.f;
        u32x2 o; o.x = pk2(x0 * m0[1], x1 * m0[3]); o.y = pk2(x2 * m1[1], x3 * m1[3]);
        float r1 = bflo(o.x) * m0[0] + bfhi(o.x) * m0[2] + bflo(o.y) * m1[0] + bfhi(o.y) * m1[2], r2 = (x0 + x1) + (x2 + x3);
        *(LAS u32x2*)(lds + SG_W + t * SG_ROW + s4 * 2) = o;
#pragma unroll
        for (int d = 1; d < 32; d <<= 1) { r1 += __shfl_xor(r1, d); r2 += __shfl_xor(r2, d); }
        if ((idx & 31) == 0) { R[t * 2] = r1; R[t * 2 + 1] = r2; } }
    const int cc = h * 128 + 16 * w + fq * 4;
    u32x2 gu8[8], sz8[8];
#pragma unroll
    for (int nt = 0; nt < 8; ++nt) { const bf16_t* prow = proj + (size_t)(tok0 + nt * 16 + fr) * DIN; gu8[nt] = *(const u32x2*)(prow + C_UB + cc); sz8[nt] = *(const u32x2*)(prow + C_ZB + cc); }
    __syncthreads();
    f32x4 acc[8];
#pragma unroll
    for (int nt = 0; nt < 8; ++nt) acc[nt] = (f32x4){0.f, 0.f, 0.f, 0.f};
#pragma unroll
    for (int kk = 0; kk < 4; ++kk) {
#pragma unroll
        for (int nt = 0; nt < 8; ++nt) { const bf16x8 bq = lds16(lds + SG_W + (nt * 16 + fr) * SG_ROW + kk * 64 + fq * 16); acc[nt] = MFMA16(af[kk], bq, acc[nt]); } }
    const float* sgb = P.in[16] + (size_t)(l * 8 + h) * 128;
    const f32x4 lw = *(const f32x4*)(P.in[13] + (size_t)l * 1024 + cc), lb = *(const f32x4*)(P.in[14] + (size_t)l * 1024 + cc);
    bf16_t* yb = (bf16_t*)(P.ws + OFF_YB);
#pragma unroll
    for (int nt = 0; nt < 8; ++nt) { const int t = nt * 16 + fr; const float bias = sgb[t]; const float r1 = R[t * 2], r2 = R[t * 2 + 1];
        const u32x2 gu = gu8[nt], sz = sz8[nt];
        const float o0 = bflo(gu.x) * (lw[0] * (acc[nt][0] - r1) + lb[0] * r2 + bias) * bflo(sz.x), o1 = bfhi(gu.x) * (lw[1] * (acc[nt][1] - r1) + lb[1] * r2 + bias) * bfhi(sz.x);
        const float o2 = bflo(gu.y) * (lw[2] * (acc[nt][2] - r1) + lb[2] * r2 + bias) * bflo(sz.y), o3 = bfhi(gu.y) * (lw[3] * (acc[nt][3] - r1) + lb[3] * r2 + bias) * bfhi(sz.y);
        u32x2 o; o.x = cvt_pk_bf16(o0, o1); o.y = cvt_pk_bf16(o2, o3);
        *(u32x2*)(yb + (size_t)(tok0 + t) * 1024 + cc) = o; }
    __syncthreads();
}

constexpr int AT_KS = 0, AT_KROW = 144, AT_VT = 36864, AT_VROW = 528;
__device__ __forceinline__ void attn_item(const KParams& P, LAS unsigned char* lds, int l, int blk, int kvh, int half) {
    const int tid = launder((int)threadIdx.x), lane = tid & 63, w = __builtin_amdgcn_readfirstlane(tid >> 6), fr = lane & 15, fq = lane >> 4;
    const bf16_t* proj = (const bf16_t*)(P.ws + OFF_PROJ);
    const int n = blk & 15, b = blk >> 4, tok0 = blk * 128;
    const int tile0 = w < 6 ? w : 6;
    const int q = 16 * w + fr;
    const bf16_t* qbase = proj + (size_t)(tok0 + q) * DIN + C_Q + (kvh * 8 + half * 4) * 64 + fq * 8;
    bf16x8 qn0 = *(const bf16x8*)qbase, qn1 = *(const bf16x8*)(qbase + 32);
    {
        u32x4 kv[4], vv[4];
        const u32x4 z4 = {0u, 0u, 0u, 0u};
        const bf16_t* vtt = (const bf16_t*)(P.ws + OFF_VTT) + (size_t)(b * 2 + kvh) * 64 * 2048 + n * 128 - 128;
#pragma unroll
        for (int i = 0; i < 4; ++i) { const int idx = tid + 512 * i, row = idx >> 3, ch = idx & 7;
            kv[i] = ((n > 0) || (row >= 128)) ? *(const u32x4*)(proj + (size_t)(tok0 - 128 + row) * DIN + C_K + kvh * 64 + ch * 8) : z4; }
#pragma unroll
        for (int i = 0; i < 4; ++i) { const int idx = tid + 512 * i, d = idx >> 5, ch = idx & 31;
            vv[i] = ((n > 0) || (ch >= 16)) ? *(const u32x4*)(vtt + (size_t)d * 2048 + ch * 8) : z4; }
#pragma unroll
        for (int i = 0; i < 4; ++i) { const int idx = tid + 512 * i; *(LAS u32x4*)(lds + AT_KS + (idx >> 3) * AT_KROW + (idx & 7) * 16) = kv[i];
            *(LAS u32x4*)(lds + AT_VT + (idx >> 5) * AT_VROW + (idx & 31) * 16) = vv[i]; }
    }
    __syncthreads();
#pragma unroll 1
    for (int hh = 0; hh < 4; ++hh) {
        const int hq = kvh * 8 + half * 4 + hh;
        const bf16x8 qb0 = qn0, qb1 = qn1;
        if (hh < 3) { qn0 = *(const bf16x8*)(qbase + (hh + 1) * 64); qn1 = *(const bf16x8*)(qbase + (hh + 1) * 64 + 32); }
        const u32x2 zc0 = *(const u32x2*)(proj + (size_t)(tok0 + q) * DIN + C_ZC + hq * 64 + fq * 4);
        f32x4 s[10];
#pragma unroll
        for (int kt = 0; kt < 10; ++kt) { LAS unsigned char* kp = lds + AT_KS + ((tile0 + kt) * 16 + fr) * AT_KROW + fq * 16;
            f32x4 a = {0.f, 0.f, 0.f, 0.f}; a = MFMA16(lds16(kp), qb0, a); a = MFMA16(lds16(kp + 64), qb1, a); s[kt] = a; }
        const float sink = P.in[17][l * 16 + hq];
        float mx = sink;
#pragma unroll
        for (int kt = 0; kt < 10; ++kt)
#pragma unroll
            for (int r = 0; r < 4; ++r) { const int idx = (tile0 + kt) * 16 + fq * 4 + r; const bool ok = (idx >= q + 1) && (idx <= q + 128) && ((n > 0) || (idx >= 128));
                s[kt][r] = ok ? s[kt][r] : -1e30f; mx = fmaxf(mx, s[kt][r]); }
        mx = fmaxf(mx, __shfl_xor(mx, 16)); mx = fmaxf(mx, __shfl_xor(mx, 32));
        float sum = 0.f;
#pragma unroll
        for (int kt = 0; kt < 10; ++kt)
#pragma unroll
            for (int r = 0; r < 4; ++r) { s[kt][r] = __expf(s[kt][r] - mx); sum += s[kt][r]; }
        sum += __shfl_xor(sum, 16); sum += __shfl_xor(sum, 32);
        const float inv = 1.0f / (sum + __expf(sink - mx));
        bf16x8 pb[5];
#pragma unroll
        for (int pp = 0; pp < 5; ++pp) { u32x4 t4; t4.x = cvt_pk_bf16(s[2 * pp][0] * inv, s[2 * pp][1] * inv); t4.y = cvt_pk_bf16(s[2 * pp][2] * inv, s[2 * pp][3] * inv);
            t4.z = cvt_pk_bf16(s[2 * pp + 1][0] * inv, s[2 * pp + 1][1] * inv); t4.w = cvt_pk_bf16(s[2 * pp + 1][2] * inv, s[2 * pp + 1][3] * inv); pb[pp] = __builtin_bit_cast(bf16x8, t4); }
        bf16_t* yc = (bf16_t*)(P.ws + OFF_YC);
        const bf16_t* zrow = proj + (size_t)(tok0 + q) * DIN + C_ZC + hq * 64;
#pragma unroll
        for (int dt = 0; dt < 4; ++dt) { f32x4 o = {0.f, 0.f, 0.f, 0.f};
#pragma unroll
            for (int pp = 0; pp < 5; ++pp) { LAS unsigned char* vp = lds + AT_VT + (dt * 16 + fr) * AT_VROW + ((tile0 + 2 * pp) * 16 + fq * 4) * 2;
                o = MFMA16(cat8(*(LAS s16x4*)vp, *(LAS s16x4*)(vp + 32)), pb[pp], o); }
            const u32x2 zc = dt == 0 ? zc0 : *(const u32x2*)(zrow + dt * 16 + fq * 4);
            u32x2 ov; ov.x = cvt_pk_bf16(o[0] * bflo(zc.x), o[1] * bfhi(zc.x)); ov.y = cvt_pk_bf16(o[2] * bflo(zc.y), o[3] * bfhi(zc.y));
            *(u32x2*)(yc + (size_t)(tok0 + q) * 1024 + hq * 64 + dt * 16 + fq * 4) = ov; }
    }
    __syncthreads();
}
__global__ void __launch_bounds__(512, 2) hybrid_fwd(KParams P) {
    extern __shared__ __attribute__((aligned(16))) unsigned char lds_raw[];
    LAS unsigned char* lds = (LAS unsigned char*)lds_raw;
    cg::grid_group grid = cg::this_grid();
    unsigned char* ws = P.ws;
    const int G = gridDim.x;
    bf16_t* XN = (bf16_t*)(ws + OFF_XN); float* XB = (float*)(ws + OFF_X); bf16_t* PROJ = (bf16_t*)(ws + OFF_PROJ);
    bf16_t* YA0 = (bf16_t*)(ws + OFF_YA0); bf16_t* YA = (bf16_t*)(ws + OFF_YA); bf16_t* YB = (bf16_t*)(ws + OFF_YB); bf16_t* YC = (bf16_t*)(ws + OFF_YC);
    bf16_t* MG = (bf16_t*)(ws + OFF_MG);

    if (threadIdx.x < 16) ((LAS unsigned*)(lds + 131072))[threadIdx.x] = 0u;
    __syncthreads();
    if (blockIdx.x == 0) for (int i = threadIdx.x; i < 4096; i += 512) ((unsigned*)(ws + OFF_BAR))[i] = 0u;
    p0_prologue(P, lds);
    grid.sync();
    const XcdBarrier xb = xcd_barrier_post((unsigned*)(ws + OFF_BAR), (volatile LAS unsigned*)(lds + 131072));
#pragma unroll 1
    for (int l = 0; l < 2; ++l) {
        {
            const bf16_t* W = (const bf16_t*)(ws + OFF_WIN + (size_t)l * SZ_WIN);
            pg8::Gemm g{XN, XN, XN, W, W, W, NTOK, DIN, DM}; pg8::Order S; S.init(NTOK, DIN, G, (int)blockIdx.x, 1); S.rot = 7;
            int pm0 = -1; { pg8::Unit u0; if (S.next(0, u0)) pm0 = u0.pm; }
            EpiProj E{PROJ, (bf16_t*)(ws + OFF_VBT), (bf16_t*)(ws + OFF_VTT), (float*)(ws + OFF_ST) + (size_t)l * NTOK * 2, (const float*)(ws + OFF_ROPE), 0, (const float*)(ws + OFF_SSQ) + (size_t)l * NTOK, (bf16_t*)(ws + OFF_UA), (const LAS float*)(lds + 131072 + 64), pm0};
            for (int it = G - 1 - (int)blockIdx.x; it < 64; it += G) s5_tables_item(P, lds, l, it);
            if (pm0 >= 0 && threadIdx.x < 256) ((LAS float*)(lds + 131072 + 64))[threadIdx.x] = 1.0f / sqrtf(((const float*)(ws + OFF_SSQ))[(size_t)l * NTOK + pm0 * 256 + threadIdx.x] * (1.0f / DM) + EPS);
            __syncthreads();
            pg8::gemm_phase<EpiProj>(lds, g, S, E);
        }
        xcd_barrier(xb);
#pragma unroll 1
        for (int it = blockIdx.x; it < 768; it += G) {
            if (it < 256) s5_item(P, lds, l, it >> 6, it & 63);
            else { const int i2 = it - 256; sg_item(P, lds, l, i2 >> 3, i2 & 7); }
        }
        xcd_barrier(xb);
#pragma unroll 1
        for (int it = (G > 128) ? (((int)blockIdx.x >= 128) ? G - 1 - (int)blockIdx.x : 256) : (int)blockIdx.x; it < 256; it += (G > 128 ? G - 128 : G)) attn_item(P, lds, l, it >> 2, (it >> 1) & 1, it & 1);
        {
            const bf16_t* W = (const bf16_t*)(ws + OFF_GLU + (size_t)l * SZ_GLU);
            const int glu_lo = 0, gc = (int)blockIdx.x - glu_lo;
            pg8::Gemm g{YA0, YA0, YA0, W, W, W, NTOK, 1024, 1024}; pg8::Order S; S.init(NTOK, 1024, G - glu_lo, gc >= 0 ? gc : (1 << 20), 1);
            EpiGlu E{P.in[12] + (size_t)l * 1024, YA0, PROJ, YA};
            pg8::gemm_phase<EpiGlu>(lds, g, S, E);
        }
        xcd_barrier(xb);
        {
            const bf16_t* W0 = (const bf16_t*)(ws + OFF_WBR + (size_t)(l * 3 + 0) * SZ_WBR);
            const bf16_t* W1 = (const bf16_t*)(ws + OFF_WBR + (size_t)(l * 3 + 1) * SZ_WBR);
            const bf16_t* W2 = (const bf16_t*)(ws + OFF_WBR + (size_t)(l * 3 + 2) * SZ_WBR);
            pg8::Gemm g{YA, YB, YC, W0, W1, W2, NTOK, DM, 1024}; pg8::Order S; S.init(NTOK, DM, G, (int)blockIdx.x, 3);
            EpiMerge E{PROJ, MG};
            pg8::gemm_phase<EpiMerge>(lds, g, S, E);
        }
        xcd_barrier(xb);
        {
            const bf16_t* W = (const bf16_t*)(ws + OFF_WOUT + (size_t)l * SZ_WOUT);
            pg8::Gemm g{MG, MG, MG, W, W, W, NTOK, DM, DM}; pg8::Order S; S.init(NTOK, DM, G, (int)blockIdx.x, 1);
            EpiOut E{l == 0 ? P.in[0] : (const float*)XB, XB, l == 0 ? XN : (bf16_t*)nullptr, P.in[1] + DM, (float*)(ws + OFF_SSQ) + NTOK};
            pg8::gemm_phase<EpiOut>(lds, g, S, E);
        }
        xcd_barrier(xb);
        const int tid = launder((int)threadIdx.x), lane = tid & 63, wave = __builtin_amdgcn_readfirstlane(tid >> 6);
        const int gw = blockIdx.x * 8 + wave, NGW = G * 8;
        if (l == 0) {
        } else {
            for (int m = gw; m < NTOK; m += NGW) rms_row_f32(XB + (size_t)m * DM, P.in[22], P.out + (size_t)m * DM, lane);
        }
    }
}

extern "C" void kernel_launch(void* const* d_in, const int* in_sizes, int n_in, void* d_out, int out_size, void* d_ws, size_t ws_size, hipStream_t stream) {
    static int grid_blocks = 0;
    if (grid_blocks == 0) {
        if (n_in != 23 || ws_size < WS_END) { fprintf(stderr, "kernel_launch: unexpected n_in %d / ws_size %zu (need %zu)\n", n_in, ws_size, (size_t)WS_END); grid_blocks = -1; return; }
        int dev = 0, cus = 0, per_cu = 0;
        hipGetDevice(&dev);
        hipDeviceGetAttribute(&cus, hipDeviceAttributeMultiprocessorCount, dev);
        hipFuncSetAttribute((const void*)hybrid_fwd, hipFuncAttributeMaxDynamicSharedMemorySize, LDS_BYTES);
        hipOccupancyMaxActiveBlocksPerMultiprocessor(&per_cu, (const void*)hybrid_fwd, 512, LDS_BYTES);
        if (per_cu < 1) { fprintf(stderr, "kernel_launch: occupancy query reports %d blocks per CU\n", per_cu); per_cu = 1; }
        if (per_cu > 1) per_cu = 1;
        grid_blocks = cus * per_cu;
        (void)hipGetLastError();
    }
    if (grid_blocks < 0) return;
    KParams p{};
    for (int i = 0; i < 23; ++i) p.in[i] = (const float*)d_in[i];
    p.out = (float*)d_out; p.ws = (unsigned char*)d_ws;
    void* args[] = {&p};
    hipError_t e = hipLaunchCooperativeKernel((const void*)hybrid_fwd, dim3(grid_blocks), dim3(512), args, LDS_BYTES, stream);
    if (e != hipSuccess) fprintf(stderr, "cooperative launch failed: %s (grid %d)\n", hipGetErrorString(e), grid_blocks);
}
```
